# Optimizing an MI355X kernel written in HIP

```python
import math
import jax, jax.numpy as jnp
from jax import lax
import numpy as np

D_MODEL = 1024
BATCH = 32
SEQ = 2048
DEPTH = 1

N_HEADS = 8
HEAD_DIM = 64
N_KV_HEADS = 2
IDX_HEADS = 8
IDX_DIM = 64
TOPK_MAX = 256
Q_BLOCK = 64
N_BUCKETS = 32
MAX_DISTANCE = 128
D_RNN = D_MODEL
N_RNN_BLOCKS = 8
RNN_BLOCK = D_RNN // N_RNN_BLOCKS
RNN_CONV = 4
LRU_C = 8.0
D_FF = 2816
FFN_CONV = 3
EPS = 1e-6

ATTN_WIDTH = N_HEADS * HEAD_DIM
KV_WIDTH = N_KV_HEADS * HEAD_DIM
SPLITS = (ATTN_WIDTH, KV_WIDTH, KV_WIDTH, IDX_HEADS * IDX_DIM, IDX_DIM, IDX_HEADS, D_RNN, D_RNN, D_MODEL, D_MODEL)
N_IN = 5448

kernel_name = "hybrid_dsa_rglru_convffn_block"


def rms_norm(x, g):
    x32 = x.astype(jnp.float32)
    y = x32 * lax.rsqrt(jnp.mean(x32 * x32, axis=-1, keepdims=True) + EPS)
    return (y * g.astype(jnp.float32)).astype(x.dtype)


def causal_dwconv(x, w, b):
    width = w.shape[0]
    seq = x.shape[1]
    xp = jnp.pad(x, ((0, 0), (width - 1, 0), (0, 0)))
    y = xp[:, 0:seq] * w[0]
    for k in range(1, width):
        y = y + xp[:, k:k + seq] * w[k]
    return y + b


def t5_bucket(rel):
    max_exact = N_BUCKETS // 2
    n = jnp.maximum(rel, 0)
    nf = jnp.maximum(n, 1).astype(jnp.float32)
    large = max_exact + (jnp.log(nf / max_exact) / math.log(MAX_DISTANCE / max_exact)
                         * (N_BUCKETS - max_exact)).astype(jnp.int32)
    large = jnp.minimum(large, N_BUCKETS - 1)
    return jnp.where(n < max_exact, n, large)


def dsa_attention(q, k, v, q_idx, k_idx, w_idx, rel_bias):
    B, S = q.shape[0], q.shape[1]
    n_sel = min(TOPK_MAX, S // 4)
    nb = S // Q_BLOCK
    G = N_HEADS // N_KV_HEADS
    pos = jnp.arange(S, dtype=jnp.int32)
    gather = jax.vmap(lambda t_b, i_b: t_b[i_b])

    def to_blocks(t):
        return jnp.moveaxis(t.reshape((B, nb, Q_BLOCK) + t.shape[2:]), 1, 0)

    def block(args):
        qb, qib, wb, tb = args
        dots = jnp.einsum('bqhd,bsd->bqhs', qib, k_idx).astype(jnp.float32) * (IDX_DIM ** -0.5)
        score = jnp.einsum('bqh,bqhs->bqs', wb.astype(jnp.float32) * (IDX_HEADS ** -0.5), jax.nn.relu(dots))
        causal = pos[None, :] <= tb[:, None]
        score = jnp.where(causal[None], score, -jnp.inf)
        _, sel = lax.top_k(score, n_sel)
        valid = sel <= tb[None, :, None]
        ks = gather(k, sel)
        vs = gather(v, sel)
        qg = qb.reshape(B, Q_BLOCK, N_KV_HEADS, G, HEAD_DIM)
        logits = jnp.einsum('bqhgd,bqnhd->bqhgn', qg, ks).astype(jnp.float32) * (HEAD_DIM ** -0.5)
        bucket = t5_bucket(tb[None, :, None] - sel)
        bias = rel_bias[bucket].astype(jnp.float32)
        bias = bias.reshape(B, Q_BLOCK, n_sel, N_KV_HEADS, G).transpose(0, 1, 3, 4, 2)
        logits = jnp.where(valid[:, :, None, None, :], logits + bias, -jnp.inf)
        p = jax.nn.softmax(logits, axis=-1).astype(vs.dtype)
        o = jnp.einsum('bqhgn,bqnhd->bqhgd', p, vs)
        return o.reshape(B, Q_BLOCK, N_HEADS * HEAD_DIM)

    out = lax.map(block, (to_blocks(q), to_blocks(q_idx), to_blocks(w_idx), pos.reshape(nb, Q_BLOCK)))
    return jnp.moveaxis(out, 0, 1).reshape(B, S, N_HEADS * HEAD_DIM)


def rg_lru(x, w_rg, b_rg, w_ig, b_ig, lam):
    B, S = x.shape[0], x.shape[1]
    xb = x.reshape(B, S, N_RNN_BLOCKS, RNN_BLOCK)
    r = jax.nn.sigmoid(jnp.einsum('bsnc,ncd->bsnd', xb, w_rg).reshape(B, S, D_RNN) + b_rg)
    i = jax.nn.sigmoid(jnp.einsum('bsnc,ncd->bsnd', xb, w_ig).reshape(B, S, D_RNN) + b_ig)
    log_a = -LRU_C * r.astype(jnp.float32) * jax.nn.softplus(-lam.astype(jnp.float32))
    a = jnp.exp(log_a)
    mult = jnp.sqrt(-jnp.expm1(2.0 * log_a))
    u = x.astype(jnp.float32) * i.astype(jnp.float32) * mult

    def combine(left, right):
        a1, b1 = left
        a2, b2 = right
        return a1 * a2, a2 * b1 + b2

    _, h = lax.associative_scan(combine, (a, u), axis=1)
    return h.astype(x.dtype)


def setup_inputs(seed: int = 0) -> dict:
    key = jax.random.key(seed)
    ks = jax.random.split(key, 32)
    f32 = jnp.float32

    def nrm(k, shape, scale):
        return jax.random.normal(k, shape, f32) * scale

    L = DEPTH
    a0 = jax.random.uniform(ks[13], (L, D_RNN), f32, 0.9, 0.999)
    p = a0 ** (1.0 / LRU_C)
    lam = jnp.log(p) - jnp.log1p(-p)
    return {
        "x": nrm(ks[0], (BATCH, SEQ, D_MODEL), 1.0),
        "c": nrm(ks[1], (BATCH, D_MODEL), 1.0),
        "w_ada": nrm(ks[2], (L, D_MODEL, 6 * D_MODEL), D_MODEL ** -0.5),
        "b_ada": nrm(ks[3], (L, 6 * D_MODEL), 0.02),
        "g_mix": 1.0 + nrm(ks[4], (L, D_MODEL), 0.02),
        "w_in": nrm(ks[5], (L, D_MODEL, N_IN), D_MODEL ** -0.5),
        "b_in": nrm(ks[6], (L, N_IN), 0.01),
        "rel_bias": nrm(ks[7], (N_BUCKETS, N_HEADS), 0.5),
        "conv_rnn_w": nrm(ks[8], (L, RNN_CONV, D_RNN), RNN_CONV ** -0.5),
        "conv_rnn_b": nrm(ks[9], (L, D_RNN), 0.01),
        "w_rg": nrm(ks[10], (L, N_RNN_BLOCKS, RNN_BLOCK, RNN_BLOCK), RNN_BLOCK ** -0.5),
        "b_rg": nrm(ks[11], (L, D_RNN), 0.01),
        "w_ig": nrm(ks[12], (L, N_RNN_BLOCKS, RNN_BLOCK, RNN_BLOCK), RNN_BLOCK ** -0.5),
        "b_ig": nrm(ks[14], (L, D_RNN), 0.01),
        "lru_lambda": lam,
        "w_o_attn": nrm(ks[15], (L, ATTN_WIDTH, D_MODEL), ATTN_WIDTH ** -0.5),
        "w_o_rnn": nrm(ks[16], (L, D_RNN, D_MODEL), D_RNN ** -0.5),
        "w_out": nrm(ks[17], (L, D_MODEL, D_MODEL), D_MODEL ** -0.5),
        "g_ffn": 1.0 + nrm(ks[18], (L, D_MODEL), 0.02),
        "w_up": nrm(ks[19], (L, D_MODEL, 2 * D_FF), D_MODEL ** -0.5),
        "conv_ffn_w": nrm(ks[20], (L, FFN_CONV, 2 * D_FF), FFN_CONV ** -0.5),
        "conv_ffn_b": nrm(ks[21], (L, 2 * D_FF), 0.01),
        "w_down": nrm(ks[22], (L, D_FF, D_MODEL), D_FF ** -0.5),
        "g_final": 1.0 + nrm(ks[23], (D_MODEL,), 0.02),
    }


def reference(x, c, w_ada, b_ada, g_mix, w_in, b_in, rel_bias, conv_rnn_w, conv_rnn_b,
              w_rg, b_rg, w_ig, b_ig, lru_lambda, w_o_attn, w_o_rnn, w_out, g_ffn,
              w_up, conv_ffn_w, conv_ffn_b, w_down, g_final):
    B, S = x.shape[0], x.shape[1]
    cuts = []
    acc = 0
    for width in SPLITS[:-1]:
        acc += width
        cuts.append(acc)
    c_act = jax.nn.silu(c)
    h = x
    for l in range(DEPTH):
        mod = jnp.dot(c_act, w_ada[l]) + b_ada[l]
        sh1, sc1, ga1, sh2, sc2, ga2 = [m[:, None, :] for m in jnp.split(mod, 6, axis=-1)]

        xn = rms_norm(h, g_mix[l]) * (1.0 + sc1) + sh1
        proj = jnp.dot(xn, w_in[l]) + b_in[l]
        q, k, v, qi, ki, wi, xr, yr, gate_a, gate_b = jnp.split(proj, cuts, axis=-1)

        attn = dsa_attention(
            q.reshape(B, S, N_HEADS, HEAD_DIM),
            k.reshape(B, S, N_KV_HEADS, HEAD_DIM),
            v.reshape(B, S, N_KV_HEADS, HEAD_DIM),
            qi.reshape(B, S, IDX_HEADS, IDX_DIM), ki, wi, rel_bias)

        xr = causal_dwconv(xr, conv_rnn_w[l], conv_rnn_b[l])
        rnn = rg_lru(xr, w_rg[l], b_rg[l], w_ig[l], b_ig[l], lru_lambda[l]) * jax.nn.gelu(yr)

        merged = (jax.nn.sigmoid(gate_a) * jnp.dot(attn, w_o_attn[l])
                  + jax.nn.sigmoid(gate_b) * jnp.dot(rnn, w_o_rnn[l]))
        h = h + ga1 * jnp.dot(merged, w_out[l])

        xn = rms_norm(h, g_ffn[l]) * (1.0 + sc2) + sh2
        up = causal_dwconv(jnp.dot(xn, w_up[l]), conv_ffn_w[l], conv_ffn_b[l])
        val, gte = jnp.split(up, 2, axis=-1)
        h = h + ga2 * jnp.dot(jax.nn.silu(gte) * val, w_down[l])
    return rms_norm(h, g_final)
```

```cpp
#define MK_N_LAUNCHES 14
#include <hip/hip_runtime.h>
#include <cstdio>
#include <cstdint>
namespace pg8 {
#define PG8_LAS __attribute__((address_space(3)))
typedef unsigned short bf16_t;
typedef short bf16x8 __attribute__((ext_vector_type(8)));
typedef float f32x4 __attribute__((ext_vector_type(4)));
typedef unsigned u32x4 __attribute__((ext_vector_type(4)));
constexpr int BM = 256, BK = 64, HALF = 128, HTB = HALF * BK * 2  , STAGE_BYTES = 8 * HTB, NXCD = 8, WGM = 8;

__host__ __device__ __forceinline__ int lds_byte(int r, int c) { const int st = (r >> 4) * 2 + (c >> 5), rr = r & 15, cc = c & 31, ob = rr * 64 + cc * 2; return st * 1024 + (ob ^ (((ob >> 9) & 1) << 5)); }
__host__ __device__ __forceinline__ void stage_rc(int b, int& R, int& C) { const int st = b / 1024, sb = b % 1024, swz = sb ^ (((sb >> 9) & 1) << 5); R = (st >> 1) * 16 + swz / 64; C = (st & 1) * 32 + (swz % 64) / 2; }
__host__ __device__ __forceinline__ int perm32(int rho) { const int n = rho >> 4, i = rho & 15; return 8 * (i >> 2) + 4 * n + (i & 3); }

struct Unit { int pm, pn; };
struct Gemm { const bf16_t* A; const bf16_t* Bt; int M, N, K, lda, ldb; };

struct StaticOrder {
    int nM, nN, nwg, G, c;
    __host__ __device__ void init(int M, int N, int G_, int c_) { nM = M / BM; nN = N / BM; nwg = nM * nN; G = G_; c = c_; }
    __host__ __device__ bool next(int i, Unit& u) const {
        const long L = (long)i * G + c; if (L >= nwg) return false;
        int wgid = (int)L; { const int q = nwg / NXCD, r = nwg % NXCD, xcd = wgid % NXCD, off = wgid / NXCD; wgid = (xcd < r ? xcd * (q + 1) : r * (q + 1) + (xcd - r) * q) + off; }
        const int nig = WGM * nN, gid = wgid / nig, fm = gid * WGM, gsz = (nM - fm) < WGM ? (nM - fm) : WGM;
        u.pm = fm + ((wgid % nig) % gsz); u.pn = (wgid % nig) / gsz; return true;
    }
    __device__ __forceinline__ void a_ready(const Unit&) const {}
    __device__ __forceinline__ void done(const Unit&) const {}
};

typedef float f32x2 __attribute__((ext_vector_type(2))); typedef __bf16 bf16x2v __attribute__((ext_vector_type(2)));
__device__ __forceinline__ unsigned cvt_pk_bf16(float lo, float hi) { f32x2 v = {lo, hi}; bf16x2v b = __builtin_convertvector(v, bf16x2v); return __builtin_bit_cast(unsigned, b); }
typedef unsigned u32x2 __attribute__((ext_vector_type(2)));
__device__ __forceinline__ float bf_lo(unsigned u) { return __uint_as_float(u << 16); }
__device__ __forceinline__ float bf_hi(unsigned u) { return __uint_as_float(u & 0xffff0000u); }
__device__ __forceinline__ float fast_sigmoid(float x) { return __builtin_amdgcn_rcpf(1.f + __builtin_amdgcn_exp2f(-1.4426950408889634f * x)); }
__device__ __forceinline__ float gelu_tanh(float x) { const float z = 1.5957691216057308f * x * (1.f + 0.044715f * x * x); return x * fast_sigmoid(z); }

struct EpiBf16Plain {
    static constexpr bool PERM = true, AFTER_DRAIN = false;
    bf16_t* O; int ldc;
    __device__ __forceinline__ void operator()(const f32x4 (&acc)[2][2][4][2], const Unit& u, int wr, int wc, int fr, int fq) const {
        const int row0 = u.pm * BM + wr * 64 + fr, col0 = u.pn * BM + wc * 32 + 8 * fq;
#pragma unroll
        for (int ai = 0; ai < 2; ++ai)
#pragma unroll
            for (int m = 0; m < 4; ++m) { bf16_t* rowp = O + (size_t)(row0 + ai * HALF + m * 16) * ldc + col0;
#pragma unroll
                for (int bj = 0; bj < 2; ++bj) { const f32x4 v0 = acc[ai][bj][m][0], v1 = acc[ai][bj][m][1];
                    u32x4 w; w.x = cvt_pk_bf16(v0[0], v0[1]); w.y = cvt_pk_bf16(v0[2], v0[3]); w.z = cvt_pk_bf16(v1[0], v1[1]); w.w = cvt_pk_bf16(v1[2], v1[3]);
                    *(u32x4*)(rowp + bj * HALF) = w; } }
    }
};

struct EpiProj {
    static constexpr bool PERM = true, AFTER_DRAIN = false;
    bf16_t* P; int ldp; const float* bias; bf16_t* VT; int seq; float c2;
    template <int KIND> __device__ __forceinline__ void run(const f32x4 (&acc)[2][2][4][2], const Unit& u, int wr, int wc, int fr, int fq) const {
        const int row0 = u.pm * BM + wr * 64 + fr, col0 = u.pn * BM + wc * 32 + 8 * fq;
        f32x4 bv[2][2];
#pragma unroll
        for (int bj = 0; bj < 2; ++bj)
#pragma unroll
            for (int n = 0; n < 2; ++n) bv[bj][n] = *(const f32x4*)(bias + col0 + bj * HALF + 4 * n);
#pragma unroll
        for (int ai = 0; ai < 2; ++ai)
#pragma unroll
            for (int m = 0; m < 4; ++m) { const int row = row0 + ai * HALF + m * 16; bf16_t* rowp = P + (size_t)row * ldp + col0;
#pragma unroll
                for (int bj = 0; bj < 2; ++bj) { f32x4 v0 = acc[ai][bj][m][0] + bv[bj][0], v1 = acc[ai][bj][m][1] + bv[bj][1];
                    if (KIND == 0) { v0 = v0 * c2; v1 = v1 * c2; }
                    if (KIND == 3) { v0 = (f32x4){gelu_tanh(v0[0]), gelu_tanh(v0[1]), gelu_tanh(v0[2]), gelu_tanh(v0[3])}; v1 = (f32x4){gelu_tanh(v1[0]), gelu_tanh(v1[1]), gelu_tanh(v1[2]), gelu_tanh(v1[3])}; }
                    if (KIND == 4) { v0 = (f32x4){fast_sigmoid(v0[0]), fast_sigmoid(v0[1]), fast_sigmoid(v0[2]), fast_sigmoid(v0[3])}; v1 = (f32x4){fast_sigmoid(v1[0]), fast_sigmoid(v1[1]), fast_sigmoid(v1[2]), fast_sigmoid(v1[3])}; }
                    u32x4 w; w.x = cvt_pk_bf16(v0[0], v0[1]); w.y = cvt_pk_bf16(v0[2], v0[3]); w.z = cvt_pk_bf16(v1[0], v1[1]); w.w = cvt_pk_bf16(v1[2], v1[3]);
                    *(u32x4*)(rowp + bj * HALF) = w;
                    if (KIND == 1 && bj == 1) {
                        const int b = row / seq, s = row - b * seq, dv0 = wc * 32 + 8 * fq;
                        bf16_t* vt = VT + ((size_t)(b * 2 + (dv0 >> 6)) * 64 + (dv0 & 63)) * seq + s;
                        vt[0 * (size_t)seq] = (bf16_t)(w.x & 0xffffu); vt[1 * (size_t)seq] = (bf16_t)(w.x >> 16);
                        vt[2 * (size_t)seq] = (bf16_t)(w.y & 0xffffu); vt[3 * (size_t)seq] = (bf16_t)(w.y >> 16);
                        vt[4 * (size_t)seq] = (bf16_t)(w.z & 0xffffu); vt[5 * (size_t)seq] = (bf16_t)(w.z >> 16);
                        vt[6 * (size_t)seq] = (bf16_t)(w.w & 0xffffu); vt[7 * (size_t)seq] = (bf16_t)(w.w >> 16);
                    } } }
    }
    __device__ __forceinline__ void operator()(const f32x4 (&acc)[2][2][4][2], const Unit& u, int wr, int wc, int fr, int fq) const {
        const int pn = u.pn;
        if (pn < 2) run<0>(acc, u, wr, wc, fr, fq);
        else if (pn == 2) run<1>(acc, u, wr, wc, fr, fq);
        else if (pn < 10) run<2>(acc, u, wr, wc, fr, fq);
        else if (pn < 14) run<3>(acc, u, wr, wc, fr, fq);
        else run<4>(acc, u, wr, wc, fr, fq);
    }
};

template <bool ADD> struct EpiGate {
    static constexpr bool PERM = true, AFTER_DRAIN = false;
    const bf16_t* G; int ldg; const bf16_t* base; bf16_t* O; int ldc;
    __device__ __forceinline__ void operator()(const f32x4 (&acc)[2][2][4][2], const Unit& u, int wr, int wc, int fr, int fq) const {
        const int row0 = u.pm * BM + wr * 64 + fr, col0 = u.pn * BM + wc * 32 + 8 * fq;
#pragma unroll
        for (int ai = 0; ai < 2; ++ai)
#pragma unroll
            for (int m = 0; m < 4; ++m) { const size_t row = (size_t)(row0 + ai * HALF + m * 16);
#pragma unroll
                for (int bj = 0; bj < 2; ++bj) { const int col = col0 + bj * HALF;
                    const u32x4 gq = *(const u32x4*)(G + row * ldg + col);
                    f32x4 v0 = acc[ai][bj][m][0], v1 = acc[ai][bj][m][1];
                    v0 = v0 * (f32x4){bf_lo(gq.x), bf_hi(gq.x), bf_lo(gq.y), bf_hi(gq.y)}; v1 = v1 * (f32x4){bf_lo(gq.z), bf_hi(gq.z), bf_lo(gq.w), bf_hi(gq.w)};
                    if (ADD) { const u32x4 bq = *(const u32x4*)(base + row * ldc + col);
                        v0 = v0 + (f32x4){bf_lo(bq.x), bf_hi(bq.x), bf_lo(bq.y), bf_hi(bq.y)}; v1 = v1 + (f32x4){bf_lo(bq.z), bf_hi(bq.z), bf_lo(bq.w), bf_hi(bq.w)}; }
                    u32x4 w; w.x = cvt_pk_bf16(v0[0], v0[1]); w.y = cvt_pk_bf16(v0[2], v0[3]); w.z = cvt_pk_bf16(v1[0], v1[1]); w.w = cvt_pk_bf16(v1[2], v1[3]);
                    *(u32x4*)(O + row * ldc + col) = w; } }
    }
};

struct EpiResid {
    static constexpr bool PERM = false, AFTER_DRAIN = false;
    const float* base; float* out; int ldc; const float* gvec; int gstride; int seq;
    __device__ __forceinline__ void operator()(const f32x4 (&acc)[2][2][4][2], const Unit& u, int wr, int wc, int fr, int fq) const {
        const int row0 = u.pm * BM + wr * 64 + fr, col0 = u.pn * BM + wc * 32 + 4 * fq;
        const float* gv = gvec + (size_t)((u.pm * BM) / seq) * gstride;
        f32x4 g4[2][2];
#pragma unroll
        for (int bj = 0; bj < 2; ++bj)
#pragma unroll
            for (int n = 0; n < 2; ++n) g4[bj][n] = *(const f32x4*)(gv + col0 + bj * HALF + n * 16);
#pragma unroll
        for (int ai = 0; ai < 2; ++ai)
#pragma unroll
            for (int m = 0; m < 4; ++m) { const size_t off = (size_t)(row0 + ai * HALF + m * 16) * ldc + col0;
#pragma unroll
                for (int bj = 0; bj < 2; ++bj)
#pragma unroll
                    for (int n = 0; n < 2; ++n) { const f32x4 bs = *(const f32x4*)(base + off + bj * HALF + n * 16);
                        *(f32x4*)(out + off + bj * HALF + n * 16) = bs + g4[bj][n] * acc[ai][bj][m][n]; }
                if (m & 1) asm volatile("" ::: "memory"); }
    }
};

template <class Epi, class Sched, bool ALIGN_EPI = false, bool SP2 = false>
__device__ __forceinline__ void gemm_phase(PG8_LAS unsigned char* lds, const Gemm g, const Sched& S, const Epi& E) {
    const int tid = threadIdx.x, wid = __builtin_amdgcn_readfirstlane(tid >> 6), lane = tid & 63, wr = wid >> 2, wc = wid & 3, fr = lane & 15, fq = lane >> 4;
    const int K = g.K, nt = K / BK;
    unsigned voffA[2], voffB[2];
#pragma unroll
    for (int i = 0; i < 2; ++i) { int R, C; stage_rc(tid * 16 + i * 8192, R, C); const int Rb = Epi::PERM ? ((R & ~31) + perm32(R & 31)) : R;
        voffA[i] = (unsigned)(R * g.lda + C) * 2u; voffB[i] = (unsigned)(Rb * g.ldb + C) * 2u; }
    const size_t kstep = (size_t)(BK * 2);
    const size_t hstepA = (size_t)HALF * g.lda * 2, hstepB = (size_t)HALF * g.ldb * 2;
    const size_t tstepA = 2 * hstepA, tstepB = 2 * hstepB;
    const unsigned ldsw = (unsigned)wid * 1024u;
    const int aoff = lds_byte(wr * 64 + fr, fq * 8), boff = lds_byte(wc * 32 + fr, fq * 8);
#define PG8_SA(b, h) (((b) * 2 + (h)) * HTB)
#define PG8_SB(b, h) ((4 + (b) * 2 + (h)) * HTB)
#define PG8_STAGE(bufoff, gbase, voff) do { _Pragma("unroll") for (int _i = 0; _i < 2; ++_i) \
        __builtin_amdgcn_global_load_lds((const unsigned*)((const char*)(gbase) + (voff)[_i]), (PG8_LAS unsigned*)(lds + (bufoff) + ldsw + _i * 8192), 16, 0, 0); } while (0)
#define PG8_LDA(dst, b, h) do { _Pragma("unroll") for (int m = 0; m < 4; ++m) _Pragma("unroll") for (int k = 0; k < 2; ++k) dst[m][k] = *(const PG8_LAS bf16x8*)(lds + PG8_SA(b, h) + aoff + m * 2048 + k * 1024); } while (0)
#define PG8_LDB(dst, b, h) do { _Pragma("unroll") for (int n = 0; n < 2; ++n) _Pragma("unroll") for (int k = 0; k < 2; ++k) dst[n][k] = *(const PG8_LAS bf16x8*)(lds + PG8_SB(b, h) + boff + n * 2048 + k * 1024); } while (0)
#define PG8_MMA(ai, bj, At, Bt) do { __builtin_amdgcn_s_setprio(1); _Pragma("unroll") for (int m = 0; m < 4; ++m) _Pragma("unroll") for (int n = 0; n < 2; ++n) _Pragma("unroll") for (int k = 0; k < 2; ++k) \
        acc[ai][bj][m][n] = __builtin_amdgcn_mfma_f32_16x16x32_bf16(Bt[n][k], At[m][k], acc[ai][bj][m][n], 0, 0, 0); __builtin_amdgcn_s_setprio(0); } while (0)
#define PG8_WAIT_V(n) asm volatile("s_waitcnt vmcnt(" #n ")" ::: "memory")
#define PG8_WAIT_L(n) asm volatile("s_waitcnt lgkmcnt(" #n ")" ::: "memory")
#define PG8_BAR __builtin_amdgcn_s_barrier()
#define PG8_SCHED __builtin_amdgcn_sched_barrier(0)
    Unit cur, nxt; int ui = 0;
    if (!S.next(0, cur)) return;
    f32x4 acc[2][2][4][2];
#pragma unroll
    for (int a = 0; a < 2; ++a)
#pragma unroll
        for (int b = 0; b < 2; ++b)
#pragma unroll
            for (int m = 0; m < 4; ++m)
#pragma unroll
                for (int n = 0; n < 2; ++n) acc[a][b][m][n] = (f32x4){0.f, 0.f, 0.f, 0.f};
    bf16x8 At[4][2], B0[2][2], B1[2][2];
    const char* cA = (const char*)g.A + (size_t)cur.pm * tstepA; const char* cB = (const char*)g.Bt + (size_t)cur.pn * tstepB;
    S.a_ready(cur);
    if constexpr (SP2) {
        PG8_STAGE(PG8_SB(0, 0), cB, voffB); PG8_STAGE(PG8_SB(0, 1), cB + hstepB, voffB); PG8_STAGE(PG8_SA(0, 0), cA, voffA); PG8_STAGE(PG8_SA(0, 1), cA + hstepA, voffA);
        if (wr == 1) PG8_BAR;
        PG8_WAIT_V(2); PG8_BAR;
        PG8_STAGE(PG8_SB(1, 0), cB + kstep, voffB); PG8_STAGE(PG8_SA(1, 0), cA + kstep, voffA); PG8_STAGE(PG8_SB(1, 1), cB + hstepB + kstep, voffB);
        PG8_WAIT_V(6); PG8_BAR;
    } else {
        PG8_STAGE(PG8_SB(0, 0), cB, voffB); PG8_STAGE(PG8_SA(0, 0), cA, voffA); PG8_STAGE(PG8_SB(0, 1), cB + hstepB, voffB); PG8_STAGE(PG8_SA(0, 1), cA + hstepA, voffA);
        if (wr == 1) PG8_BAR;
        PG8_WAIT_V(4); PG8_BAR;
        PG8_STAGE(PG8_SB(1, 0), cB + kstep, voffB); PG8_STAGE(PG8_SA(1, 0), cA + kstep, voffA); PG8_STAGE(PG8_SB(1, 1), cB + hstepB + kstep, voffB);
        PG8_WAIT_V(6); PG8_BAR;
    }
    for (;;) {
        const bool has_next = S.next(ui + 1, nxt);
        const char* nA = has_next ? (const char*)g.A + (size_t)nxt.pm * tstepA : cA; const char* nB = has_next ? (const char*)g.Bt + (size_t)nxt.pn * tstepB : cB;
        for (int t = 0; t < nt; t += 2) {
            const bool last = (t == nt - 2);
            const char* a1 = cA + (size_t)(t + 1) * kstep;
            const char* a2 = last ? nA : cA + (size_t)(t + 2) * kstep; const char* b2 = last ? nB : cB + (size_t)(t + 2) * kstep;
            const char* a3 = a2 + kstep; const char* b3 = b2 + kstep;
            if (last && has_next) S.a_ready(nxt);
            if constexpr (SP2) {
            PG8_LDB(B0, 0, 0); PG8_LDB(B1, 0, 1); PG8_SCHED; PG8_LDA(At, 0, 0); PG8_STAGE(PG8_SA(1, 1), a1 + hstepA, voffA);
            PG8_WAIT_V(8); PG8_WAIT_L(0); PG8_BAR; PG8_MMA(0, 0, At, B0); PG8_MMA(0, 1, At, B1); PG8_BAR; PG8_SCHED;
            PG8_LDA(At, 0, 1); PG8_STAGE(PG8_SB(0, 0), b2, voffB); PG8_STAGE(PG8_SB(0, 1), b2 + hstepB, voffB); PG8_STAGE(PG8_SA(0, 0), a2, voffA);
            PG8_WAIT_V(8); PG8_WAIT_L(0); PG8_BAR; PG8_MMA(1, 0, At, B0); PG8_MMA(1, 1, At, B1); PG8_BAR; PG8_SCHED;
            PG8_LDB(B0, 1, 0); PG8_LDB(B1, 1, 1); PG8_SCHED; PG8_LDA(At, 1, 0); PG8_STAGE(PG8_SA(0, 1), a2 + hstepA, voffA);
            PG8_WAIT_V(8); PG8_WAIT_L(0); PG8_BAR; PG8_MMA(0, 0, At, B0); PG8_MMA(0, 1, At, B1); PG8_BAR; PG8_SCHED;
            PG8_LDA(At, 1, 1); PG8_STAGE(PG8_SB(1, 0), b3, voffB); PG8_STAGE(PG8_SB(1, 1), b3 + hstepB, voffB); PG8_STAGE(PG8_SA(1, 0), a3, voffA);
            PG8_WAIT_V(8); PG8_WAIT_L(0); PG8_BAR; PG8_MMA(1, 0, At, B0); PG8_MMA(1, 1, At, B1); PG8_BAR; PG8_SCHED;
            } else {
            PG8_LDB(B0, 0, 0); PG8_SCHED; PG8_LDA(At, 0, 0); PG8_STAGE(PG8_SA(1, 1), a1 + hstepA, voffA);
            PG8_WAIT_L(8); PG8_BAR; PG8_WAIT_L(0); PG8_MMA(0, 0, At, B0); PG8_BAR; PG8_SCHED;
            PG8_LDB(B1, 0, 1); PG8_STAGE(PG8_SB(0, 0), b2, voffB);
            PG8_BAR; PG8_WAIT_L(0); PG8_MMA(0, 1, At, B1); PG8_BAR;
            PG8_LDA(At, 0, 1); PG8_STAGE(PG8_SA(0, 0), a2, voffA);
            PG8_BAR; PG8_WAIT_L(0); PG8_MMA(1, 0, At, B0); PG8_BAR; PG8_SCHED;
            PG8_STAGE(PG8_SB(0, 1), b2 + hstepB, voffB);
            PG8_WAIT_V(6); PG8_BAR; PG8_MMA(1, 1, At, B1); PG8_BAR;
            PG8_LDB(B0, 1, 0); PG8_SCHED; PG8_LDA(At, 1, 0); PG8_STAGE(PG8_SA(0, 1), a2 + hstepA, voffA);
            PG8_WAIT_L(8); PG8_BAR; PG8_WAIT_L(0); PG8_MMA(0, 0, At, B0); PG8_BAR; PG8_SCHED;
            PG8_LDB(B1, 1, 1); PG8_STAGE(PG8_SB(1, 0), b3, voffB);
            PG8_BAR; PG8_WAIT_L(0); PG8_MMA(0, 1, At, B1); PG8_BAR;
            PG8_LDA(At, 1, 1); PG8_STAGE(PG8_SA(1, 0), a3, voffA);
            PG8_BAR; PG8_WAIT_L(0); PG8_MMA(1, 0, At, B0); PG8_BAR; PG8_SCHED;
            PG8_STAGE(PG8_SB(1, 1), b3 + hstepB, voffB);
            PG8_WAIT_V(6); PG8_BAR; PG8_MMA(1, 1, At, B1); PG8_BAR;
            }
        }
        if constexpr (ALIGN_EPI) { if (wr == 0) PG8_BAR; }
        if constexpr (!Epi::AFTER_DRAIN) { E(acc, cur, wr, wc, fr, fq); S.done(cur); }
        if (!has_next) break;
#pragma unroll
        for (int a = 0; a < 2; ++a)
#pragma unroll
            for (int b = 0; b < 2; ++b)
#pragma unroll
                for (int m = 0; m < 4; ++m)
#pragma unroll
                    for (int n = 0; n < 2; ++n) acc[a][b][m][n] = (f32x4){0.f, 0.f, 0.f, 0.f};
        cur = nxt; cA = nA; cB = nB; ++ui;
        if constexpr (ALIGN_EPI) { if (wr == 1) PG8_BAR; }
    }
    PG8_WAIT_V(0);
    if constexpr (!ALIGN_EPI) { if (wr == 0) PG8_BAR; }
    PG8_BAR;
    if constexpr (Epi::AFTER_DRAIN) { E.fused(acc, cur, wr, wc, fr, fq, lds, wid, lane); S.done(cur); }
#undef PG8_SA
#undef PG8_SB
#undef PG8_STAGE
#undef PG8_LDA
#undef PG8_LDB
#undef PG8_MMA
#undef PG8_WAIT_V
#undef PG8_WAIT_L
#undef PG8_BAR
#undef PG8_SCHED
}
}

#define GAS __attribute__((address_space(1)))
#define LAS __attribute__((address_space(3)))
typedef unsigned short bf16;
typedef unsigned v4u __attribute__((ext_vector_type(4)));
typedef float f32x4 __attribute__((ext_vector_type(4)));
typedef short bf16x8 __attribute__((ext_vector_type(8)));
typedef GAS unsigned gu32;
typedef GAS unsigned long long gu64;
#define RLX_AGENT __ATOMIC_RELAXED, __HIP_MEMORY_SCOPE_AGENT
#define LDS_WAIT() asm volatile("s_waitcnt lgkmcnt(0)" ::: "memory")
#define VM_WAIT() asm volatile("s_waitcnt vmcnt(0)" ::: "memory")
__device__ __forceinline__ unsigned long long rt() { return __builtin_amdgcn_s_memrealtime(); }
__device__ __forceinline__ unsigned f2bf(float f) { unsigned u = __builtin_bit_cast(unsigned, f); return (u + 0x7fffu + ((u >> 16) & 1u)) >> 16; }
__device__ __forceinline__ unsigned pk2(float lo, float hi) { return f2bf(lo) | (f2bf(hi) << 16); }

#define XB_TMO      128
#define XB_XCNT(j)  (256  + 64 * (j))
#define XB_XSUB(j)  (1280 + 64 * (j))
#define XB_XGEN(j)  (2304 + 64 * (j))
#define XB_TOP      3328
#define XB_TOPGEN   3392
#define XCD_BAR_WORDS 3456
#define XB_SPIN_CAP (1u << 18)

__device__ __forceinline__ unsigned xb_ld(unsigned* p)              { return __hip_atomic_load(p, __ATOMIC_RELAXED, __HIP_MEMORY_SCOPE_AGENT); }
__device__ __forceinline__ unsigned xb_add(unsigned* p, unsigned v) { return __hip_atomic_fetch_add(p, v, __ATOMIC_RELAXED, __HIP_MEMORY_SCOPE_AGENT); }
__device__ __forceinline__ unsigned xb_xcc_id() { return (unsigned)__builtin_amdgcn_s_getreg((3 << 11) | 20) & 0xFu; }
#define XB_SPIN(cond, bar) do { unsigned _sp = 0; while (cond) { __builtin_amdgcn_s_sleep(1); \
    if ((++_sp & 255u) == 0u) { if (xb_ld(&(bar)[XB_TMO])) break; if (_sp > XB_SPIN_CAP) { atomicAdd(&(bar)[XB_TMO], 1u); break; } } } } while (0)

struct XcdBarrier {
    unsigned* bar; unsigned x;
    volatile LAS unsigned* st;
};

__device__ __forceinline__ XcdBarrier xcd_barrier_post(unsigned* bar, volatile LAS unsigned* st) {
    XcdBarrier b; b.bar = bar; b.x = xb_xcc_id(); b.st = st;
    if (threadIdx.x == 0) (void)xb_add(&bar[XB_XCNT(b.x)], 1u);
    return b;
}
__device__ __forceinline__ void xcd_barrier_complete(unsigned* bar, unsigned x, unsigned& nloc, unsigned& nx) {
    const unsigned G = gridDim.x * gridDim.y * gridDim.z;
    unsigned sum, cnt, mine, sp = 0u;
    for (;;) {
        sum = 0u; cnt = 0u; mine = 0u;
#pragma unroll
        for (unsigned j = 0; j < 16; ++j) { const unsigned c = xb_ld(&bar[XB_XCNT(j)]); sum += c; cnt += (c > 0u) ? 1u : 0u; mine = (j == x) ? c : mine; }
        if (sum == G) break;
        __builtin_amdgcn_s_sleep(1);
        if ((++sp & 255u) == 0u) { if (xb_ld(&bar[XB_TMO])) break; if (sp > XB_SPIN_CAP) { atomicAdd(&bar[XB_TMO], 1u); break; } }
    }
    nloc = mine > 0u ? mine : 1u; nx = cnt > 0u ? cnt : 1u;
}

__device__ __forceinline__ void xcd_barrier(const XcdBarrier& b) {
    asm volatile("s_waitcnt vmcnt(0)" ::: "memory");
    __syncthreads();
    if (threadIdx.x == 0) {
        unsigned* bar = b.bar;
        __builtin_amdgcn_s_waitcnt(0);
        unsigned nloc = b.st[0], nx = b.st[1];
        if (nloc == 0u) { xcd_barrier_complete(bar, b.x, nloc, nx); b.st[0] = nloc; b.st[1] = nx; }
        const unsigned old = xb_add(&bar[XB_XSUB(b.x)], 1u);
        const unsigned gen = old / nloc;
        if (old + 1u == (gen + 1u) * nloc) {
            __builtin_amdgcn_fence(__ATOMIC_RELEASE, "agent");
            asm volatile("s_waitcnt vmcnt(0)" ::: "memory");
            const unsigned og = xb_add(&bar[XB_TOP], 1u);
            const unsigned tg = og / nx;
            if (og + 1u == (tg + 1u) * nx) xb_add(&bar[XB_TOPGEN], 1u);
            else XB_SPIN(xb_ld(&bar[XB_TOPGEN]) == tg, bar);
            __builtin_amdgcn_fence(__ATOMIC_ACQUIRE, "agent");
            xb_add(&bar[XB_XGEN(b.x)], 1u);
            asm volatile("s_waitcnt vmcnt(0)" ::: "memory");
        } else {
            XB_SPIN(xb_ld(&bar[XB_XGEN(b.x)]) == gen, bar);
            __builtin_amdgcn_fence(__ATOMIC_ACQUIRE, "agent");
            asm volatile("s_waitcnt vmcnt(0)" ::: "memory");
        }
    }
    __syncthreads();
}

constexpr int NWAVES = 8;
constexpr int BATCH = 32, SEQ = 2048, D = 1024, M = BATCH * SEQ;
constexpr int NH = 8, HD = 64, NKV = 2, IH = 8, IDIM = 64, NSEL = 256;
constexpr int DFF = 2816, NIN = 5448, NMOD = 6 * D;
constexpr int LDP = 5632;
constexpr int PC_Q = 0, PC_K = 512, PC_V = 640, PC_QI = 768, PC_KI = 1280, PC_WI = 1344, PC_XR = 1536, PC_YR = 2560, PC_GA = 3584, PC_GB = 4608;
constexpr int LDAR = 1536;
constexpr int HFF = DFF / 2;
constexpr float EPS = 1e-6f, LOG2E = 1.4426950408889634f, QSCALE = 0.125f * 1.4426950408889634f;

constexpr size_t MiB = 1u << 20;
constexpr size_t WS_CTL = 0, CTL_ZERO_BYTES = 1 * MiB;
constexpr size_t WS_MOD = 1 * MiB;
constexpr size_t WS_BIASP = 1 * MiB + 832 * 1024;
constexpr size_t WS_WIN = 2 * MiB, WS_WUP = 13 * MiB, WS_WDN = 24 * MiB, WS_WOA = 30 * MiB, WS_WOR = 31 * MiB, WS_WOUT = 33 * MiB, WS_WRG = 35 * MiB, WS_WIG = 35 * MiB + 512 * 1024;
constexpr size_t WS_VT = 40 * MiB;
constexpr size_t WS_A = 64 * MiB;
constexpr size_t WS_ACT = WS_A + 352 * MiB;
constexpr size_t WS_B = 768 * MiB;
constexpr size_t WS_C = 896 * MiB;
constexpr size_t WS_END = 1024 * MiB;
static_assert(WS_MOD + (size_t)BATCH * NMOD * 4 <= WS_BIASP && WS_BIASP + LDP * 4 <= WS_WIN, "ws map");
static_assert(WS_WIN + (size_t)LDP * D * 2 <= WS_WUP && WS_WUP + (size_t)LDP * D * 2 <= WS_WDN && WS_WDN + (size_t)D * DFF * 2 <= WS_WOA, "ws map");
static_assert(WS_A + (size_t)M * LDP * 2 <= WS_B && WS_ACT + (size_t)M * DFF * 2 <= WS_B && WS_B + (size_t)M * D * 2 <= WS_C && WS_C + (size_t)M * D * 2 <= WS_END, "ws map");
constexpr int CW_TMO = 0, CW_CODE = 1, CW_BAR = 4096;

constexpr int RING_OFF = 0, RING_BYTES = 131072;
constexpr int LDSCTL_OFF = RING_BYTES, MISC_OFF = LDSCTL_OFF + 320;
constexpr int LDS_BYTES = 147456;


typedef unsigned u32x2 __attribute__((ext_vector_type(2)));
typedef float f32x16 __attribute__((ext_vector_type(16)));
struct Frame {
    LAS unsigned char* lds;
    volatile LAS unsigned* MISC;
    gu32* ctl;
    int tid, lane, wave;
    int vcu, G;
    const float *x, *c, *w_ada, *b_ada, *g_mix, *w_in, *b_in, *rel_bias, *conv_rnn_w, *conv_rnn_b, *w_rg, *b_rg, *w_ig, *b_ig, *lru_lambda,
                *w_o_attn, *w_o_rnn, *w_out, *g_ffn, *w_up, *conv_ffn_w, *conv_ffn_b, *w_down, *g_final;
    float* out;
    float *mod, *biasp;
    bf16 *Win_t, *Wup_t, *Wdn_t, *Woa_t, *Wor_t, *Wout_t, *Wrg_t, *Wig_t;
    bf16 *VT, *P, *UPH, *ACT, *XN, *T1, *MG, *AR;
};
__device__ __forceinline__ float bf2f_lo(unsigned u) { return __uint_as_float(u << 16); }
__device__ __forceinline__ float bf2f_hi(unsigned u) { return __uint_as_float(u & 0xffff0000u); }
__device__ __forceinline__ float bf1(bf16 v) { return __uint_as_float(((unsigned)v) << 16); }
typedef float f32x2_t __attribute__((ext_vector_type(2))); typedef __bf16 bf16x2_t __attribute__((ext_vector_type(2)));
__device__ __forceinline__ unsigned cvtpk(float lo, float hi) { f32x2_t v = {lo, hi}; bf16x2_t b = __builtin_convertvector(v, bf16x2_t); return __builtin_bit_cast(unsigned, b); }
__device__ __forceinline__ float wave_sum(float v) {
#pragma unroll
    for (int o = 1; o < 64; o <<= 1) v += __shfl_xor(v, o);
    return v;
}
__device__ __forceinline__ float sigmoidf_(float x) { return __builtin_amdgcn_rcpf(1.f + __builtin_amdgcn_exp2f(-LOG2E * x)); }

__device__ __forceinline__ void tr_item(const float* W, int ldw, int k0, int c0, int nvalid, bf16* WT, int ldt, int r0, LAS float* scr, int lane) {
#pragma unroll 8
    for (int i = 0; i < 32; ++i) { const int kk = 2 * i + (lane >> 5), n = lane & 31; scr[kk * 33 + n] = (n < nvalid) ? W[(size_t)(k0 + kk) * ldw + c0 + n] : 0.f; }
    LDS_WAIT(); asm volatile("" ::: "memory");
    const int c = lane & 7;
#pragma unroll
    for (int j = 0; j < 4; ++j) { const int n = (lane >> 3) + 8 * j; const LAS float* s = scr + (8 * c) * 33 + n;
        v4u o; o.x = pk2(s[0 * 33], s[1 * 33]); o.y = pk2(s[2 * 33], s[3 * 33]); o.z = pk2(s[4 * 33], s[5 * 33]); o.w = pk2(s[6 * 33], s[7 * 33]);
        *(GAS v4u*)(WT + (size_t)(r0 + n) * ldt + k0 + 8 * c) = o; }
    LDS_WAIT(); asm volatile("" ::: "memory");
}
__device__ __forceinline__ int proj_src_col(int d) { return d < 1352 ? d : (d >= 1536 ? d - 184 : -1); }

__device__ __forceinline__ void p0_prologue(Frame& F) {
    LAS float* scr = (LAS float*)(F.lds + RING_OFF + F.wave * 16384);
    const int gw = F.vcu * NWAVES + F.wave, NGW = F.G * NWAVES;
    constexpr int I_IN = 16 * 176, I_UP = 16 * 176, I_DN = 44 * 32, I_OA = 8 * 32, I_OR = 16 * 32, I_OUT = 16 * 32, I_RG = 64, I_IG = 64;
    constexpr int NITEMS = I_IN + I_UP + I_DN + I_OA + I_OR + I_OUT + I_RG + I_IG;
    for (int it = gw; it < NITEMS; it += NGW) {
        int r = it;
        if (r < I_IN) { const int kb = r / 176, d0 = 32 * (r % 176); int c0 = 0, nv = 32;
            if (d0 < 1344) c0 = d0; else if (d0 == 1344) { c0 = 1344; nv = 8; } else if (d0 < 1536) { c0 = 0; nv = 0; } else c0 = d0 - 184;
            tr_item(F.w_in, NIN, 64 * kb, c0, nv, F.Win_t, D, d0, scr, F.lane); continue; } r -= I_IN;
        if (r < I_UP) { const int kb = r / 176, d0 = 32 * (r % 176); const int seg = d0 / HFF, off = d0 - seg * HFF;
            const int c0 = (seg == 0) ? off : (seg == 1) ? DFF + off : (seg == 2) ? HFF + off : DFF + HFF + off;
            tr_item(F.w_up, 2 * DFF, 64 * kb, c0, 32, F.Wup_t, D, d0, scr, F.lane); continue; } r -= I_UP;
        if (r < I_DN) { const int kb = r / 32, nb = r % 32; tr_item(F.w_down, D, 64 * kb, 32 * nb, 32, F.Wdn_t, DFF, 32 * nb, scr, F.lane); continue; } r -= I_DN;
        if (r < I_OA) { const int kb = r / 32, nb = r % 32; tr_item(F.w_o_attn, D, 64 * kb, 32 * nb, 32, F.Woa_t, 512, 32 * nb, scr, F.lane); continue; } r -= I_OA;
        if (r < I_OR) { const int kb = r / 32, nb = r % 32; tr_item(F.w_o_rnn, D, 64 * kb, 32 * nb, 32, F.Wor_t, D, 32 * nb, scr, F.lane); continue; } r -= I_OR;
        if (r < I_OUT) { const int kb = r / 32, nb = r % 32; tr_item(F.w_out, D, 64 * kb, 32 * nb, 32, F.Wout_t, D, 32 * nb, scr, F.lane); continue; } r -= I_OUT;
        if (r < I_RG) { const int blk = r / 8, rr = r % 8, kb = rr / 4, nb = rr % 4; tr_item(F.w_rg + blk * 16384, 128, 64 * kb, 32 * nb, 32, F.Wrg_t + blk * 16384, 128, 32 * nb, scr, F.lane); continue; } r -= I_RG;
        { const int blk = r / 8, rr = r % 8, kb = rr / 4, nb = rr % 4; tr_item(F.w_ig + blk * 16384, 128, 64 * kb, 32 * nb, 32, F.Wig_t + blk * 16384, 128, 32 * nb, scr, F.lane); }
    }
    for (int d = F.vcu * (NWAVES * 64) + F.tid; d < LDP; d += F.G * NWAVES * 64) { const int s = proj_src_col(d); F.biasp[d] = (s >= 0) ? F.b_in[s] : 0.f; }
    __syncthreads();
    for (int item = F.vcu; item < NMOD / 64; item += F.G) {
        LAS float* cs = (LAS float*)(F.lds + RING_OFF);
        for (int i = F.tid; i < BATCH * D; i += NWAVES * 64) { const float v = F.c[i]; cs[i] = v * sigmoidf_(v); }
        __syncthreads();
        const int col = item * 64 + F.lane, kbase = F.wave * 128;
        float acc[BATCH];
#pragma unroll
        for (int b = 0; b < BATCH; ++b) acc[b] = 0.f;
        for (int k4 = 0; k4 < 32; ++k4) {
            const int k = kbase + 4 * k4;
            const float w0 = F.w_ada[(size_t)(k + 0) * NMOD + col], w1 = F.w_ada[(size_t)(k + 1) * NMOD + col], w2 = F.w_ada[(size_t)(k + 2) * NMOD + col], w3 = F.w_ada[(size_t)(k + 3) * NMOD + col];
#pragma unroll
            for (int b = 0; b < BATCH; ++b) { const f32x4 c4 = *(const LAS f32x4*)(cs + b * D + k); acc[b] += (c4.x * w0 + c4.y * w1) + (c4.z * w2 + c4.w * w3); }
        }
        __syncthreads();
        LAS float* red = (LAS float*)(F.lds + RING_OFF);
#pragma unroll
        for (int b = 0; b < BATCH; ++b) red[(F.wave * BATCH + b) * 64 + F.lane] = acc[b];
        __syncthreads();
        for (int o = F.tid; o < BATCH * 64; o += NWAVES * 64) { const int b = o >> 6, l = o & 63; float s = F.b_ada[item * 64 + l];
#pragma unroll
            for (int w = 0; w < NWAVES; ++w) s += red[(w * BATCH + b) * 64 + l];
            F.mod[(size_t)b * NMOD + item * 64 + l] = s; }
        __syncthreads();
    }
}

__device__ __forceinline__ void p_norm_mod(Frame& F, const float* src, bf16* dst, const float* g, int sh_off, int sc_off) {
    const int gw = F.vcu * NWAVES + F.wave, NGW = F.G * NWAVES;
    for (int rb = gw; rb < M / 32; rb += NGW) {
        const int b = rb / (SEQ / 32);
        const float* mb = F.mod + (size_t)b * NMOD;
        f32x4 gm[4], sh[4];
#pragma unroll
        for (int j = 0; j < 4; ++j) { const int col = 4 * F.lane + 256 * j; const f32x4 gg = *(const f32x4*)(g + col), sc = *(const f32x4*)(mb + sc_off + col); sh[j] = *(const f32x4*)(mb + sh_off + col); gm[j] = gg * (sc + 1.0f); }
        for (int r = 0; r < 32; ++r) {
            const size_t row = (size_t)rb * 32 + r;
            const GAS f32x4* xr = (const GAS f32x4*)(src + row * D) + F.lane;
            f32x4 v[4]; float s = 0.f;
#pragma unroll
            for (int j = 0; j < 4; ++j) { v[j] = xr[64 * j]; s += (v[j].x * v[j].x + v[j].y * v[j].y) + (v[j].z * v[j].z + v[j].w * v[j].w); }
            const float rstd = 1.0f / sqrtf(wave_sum(s) * (1.f / D) + EPS);
            GAS u32x2* o8 = (GAS u32x2*)(dst + row * D) + F.lane;
#pragma unroll
            for (int j = 0; j < 4; ++j) { const f32x4 o = v[j] * rstd * gm[j] + sh[j]; u32x2 w; w.x = cvtpk(o.x, o.y); w.y = cvtpk(o.z, o.w); o8[64 * j] = w; }
        }
    }
}
__device__ __forceinline__ void p_norm_final(Frame& F) {
    const int gw = F.vcu * NWAVES + F.wave, NGW = F.G * NWAVES;
    f32x4 gm[4];
#pragma unroll
    for (int j = 0; j < 4; ++j) gm[j] = *(const f32x4*)(F.g_final + 4 * F.lane + 256 * j);
    for (int rb = gw; rb < M / 32; rb += NGW)
        for (int r = 0; r < 32; ++r) {
            const size_t row = (size_t)rb * 32 + r;
            GAS f32x4* xr = (GAS f32x4*)(F.out + row * D) + F.lane;
            f32x4 v[4]; float s = 0.f;
#pragma unroll
            for (int j = 0; j < 4; ++j) { v[j] = xr[64 * j]; s += (v[j].x * v[j].x + v[j].y * v[j].y) + (v[j].z * v[j].z + v[j].w * v[j].w); }
            const float rstd = 1.0f / sqrtf(wave_sum(s) * (1.f / D) + EPS);
#pragma unroll
            for (int j = 0; j < 4; ++j) xr[64 * j] = v[j] * rstd * gm[j];
        }
}

__device__ __forceinline__ void p_act(Frame& F, int half) {
    constexpr int NCG = HFF / 8;
    const int T = F.vcu * (NWAVES * 64) + F.tid, NT = F.G * NWAVES * 64, nslots = NT / NCG;
    if (T >= nslots * NCG) return;
    const int cg = T % NCG, slot = T / NCG;
    const int j0 = cg * 8, jg = half * HFF + j0;
    float wv[3][8], wg[3][8], bv[8], bg[8];
#pragma unroll
    for (int k = 0; k < 3; ++k)
#pragma unroll
        for (int e = 0; e < 8; ++e) { wv[k][e] = F.conv_ffn_w[(size_t)k * (2 * DFF) + jg + e]; wg[k][e] = F.conv_ffn_w[(size_t)k * (2 * DFF) + DFF + jg + e]; }
#pragma unroll
    for (int e = 0; e < 8; ++e) { bv[e] = F.conv_ffn_b[jg + e]; bg[e] = F.conv_ffn_b[DFF + jg + e]; }
    for (int rc = slot; rc < M / 16; rc += nslots) {
        const size_t t0 = (size_t)rc * 16;
        const bool first = (t0 % SEQ) == 0;
        const bf16* up = F.UPH + t0 * DFF + j0;
        v4u v2 = {0, 0, 0, 0}, v1 = {0, 0, 0, 0}, g2 = {0, 0, 0, 0}, g1 = {0, 0, 0, 0};
        if (!first) { v2 = *(const v4u*)(up - 2 * (ptrdiff_t)DFF); v1 = *(const v4u*)(up - (ptrdiff_t)DFF); g2 = *(const v4u*)(up - 2 * (ptrdiff_t)DFF + HFF); g1 = *(const v4u*)(up - (ptrdiff_t)DFF + HFF); }
        bf16* ap = F.ACT + t0 * DFF + jg;
#pragma unroll 4
        for (int r = 0; r < 16; ++r) {
            const v4u v0 = *(const v4u*)(up + (size_t)r * DFF), g0 = *(const v4u*)(up + (size_t)r * DFF + HFF);
            float o[8];
#pragma unroll
            for (int q = 0; q < 4; ++q) {
                const unsigned a2 = v2[q], a1 = v1[q], a0 = v0[q], c2 = g2[q], c1 = g1[q], c0 = g0[q];
                const float vl = wv[0][2 * q] * bf2f_lo(a2) + wv[1][2 * q] * bf2f_lo(a1) + wv[2][2 * q] * bf2f_lo(a0) + bv[2 * q];
                const float vh = wv[0][2 * q + 1] * bf2f_hi(a2) + wv[1][2 * q + 1] * bf2f_hi(a1) + wv[2][2 * q + 1] * bf2f_hi(a0) + bv[2 * q + 1];
                const float gl = wg[0][2 * q] * bf2f_lo(c2) + wg[1][2 * q] * bf2f_lo(c1) + wg[2][2 * q] * bf2f_lo(c0) + bg[2 * q];
                const float gh = wg[0][2 * q + 1] * bf2f_hi(c2) + wg[1][2 * q + 1] * bf2f_hi(c1) + wg[2][2 * q + 1] * bf2f_hi(c0) + bg[2 * q + 1];
                o[2 * q] = gl * sigmoidf_(gl) * vl; o[2 * q + 1] = gh * sigmoidf_(gh) * vh;
            }
            v4u w; w.x = cvtpk(o[0], o[1]); w.y = cvtpk(o[2], o[3]); w.z = cvtpk(o[4], o[5]); w.w = cvtpk(o[6], o[7]);
            *(v4u*)(ap + (size_t)r * DFF) = w;
            v2 = v1; v1 = v0; g2 = g1; g1 = g0;
        }
    }
}

__constant__ unsigned char T5_BUCKET[128] = {
    0, 1, 2, 3, 4, 5, 6, 7, 8, 9, 10, 11, 12, 13, 14, 15, 16, 16, 16, 17, 17, 18, 18, 18, 19, 19, 19, 20, 20, 20, 20, 21, 21, 21, 21, 22, 22, 22, 22, 22,
    23, 23, 23, 23, 23, 23, 24, 24, 24, 24, 24, 24, 25, 25, 25, 25, 25, 25, 25, 26, 26, 26, 26, 26, 26, 26, 26, 27, 27, 27, 27, 27, 27, 27, 27, 27, 27,
    28, 28, 28, 28, 28, 28, 28, 28, 28, 28, 29, 29, 29, 29, 29, 29, 29, 29, 29, 29, 29, 29, 30, 30, 30, 30, 30, 30, 30, 30, 30, 30, 30, 30, 30, 30,
    31, 31, 31, 31, 31, 31, 31, 31, 31, 31, 31, 31, 31, 31, 31};
constexpr int ATT_MASK_OFF = 0, ATT_TBL_OFF = 16384;
__device__ __forceinline__ unsigned ord_key(float s) { const unsigned u = __float_as_uint(s); return (u & 0x80000000u) ? ~u : (u | 0x80000000u); }

__device__ __forceinline__ void attn_unit(Frame& F, int b, int qb) {
    const int lane = F.lane, w = F.wave, l32 = lane & 31, g = lane >> 5;
    LAS unsigned* maskL = (LAS unsigned*)(F.lds + RING_OFF + ATT_MASK_OFF);
    const LAS float* tbl = (const LAS float*)(F.lds + RING_OFF + ATT_TBL_OFF);
    const size_t tok0 = (size_t)b * SEQ;
    const int qw = qb * 64 + 8 * w;
    const int nkt = 2 * (qb + 1);
    const bf16* Pb = F.P + tok0 * LDP;

#ifndef NO_PASS1
    for (int tile = 0; tile < 2; ++tile) {
        const int qq = 2 * ((l32 >> 2) & 1) + (l32 >> 4), hd = ((l32 >> 3) & 1) * 4 + (l32 & 3);
        const bf16* qrow = Pb + (size_t)(qw + 4 * tile + qq) * LDP + PC_QI + hd * 64 + 8 * g;
        bf16x8 af[4];
#pragma unroll
        for (int ks = 0; ks < 4; ++ks) af[ks] = *(const bf16x8*)(qrow + 16 * ks);
        const int t0q = qw + 4 * tile + 2 * g;
        float wq[2][8];
#pragma unroll
        for (int e = 0; e < 2; ++e) { const v4u wv = *(const v4u*)(Pb + (size_t)(t0q + e) * LDP + PC_WI);
            wq[e][0] = bf2f_lo(wv.x); wq[e][1] = bf2f_hi(wv.x); wq[e][2] = bf2f_lo(wv.y); wq[e][3] = bf2f_hi(wv.y); wq[e][4] = bf2f_lo(wv.z); wq[e][5] = bf2f_hi(wv.z); wq[e][6] = bf2f_lo(wv.w); wq[e][7] = bf2f_hi(wv.w); }
        unsigned keys[64][2];
        int l32v = l32; asm volatile("" : "+v"(l32v));
        const GAS char* pbase = (const GAS char*)Pb; asm volatile("" : "+s"(pbase));
        int nktv = nkt; asm volatile("" : "+s"(nktv));
        const unsigned kvoff = (unsigned)((l32v * LDP + PC_KI + 8 * g) * 2);
        bf16x8 bq[2][4];
#pragma unroll
        for (int ks = 0; ks < 4; ++ks) { bq[0][ks] = *(const GAS bf16x8*)(pbase + kvoff + 32 * ks); bq[1][ks] = bq[0][ks]; }
#pragma unroll
        for (int kt = 0; kt < 64; ++kt) {
            if (kt < nktv) {
                if (kt + 1 < nktv) {
#pragma unroll
                    for (int ks = 0; ks < 4; ++ks) bq[(kt + 1) & 1][ks] = *(const GAS bf16x8*)(pbase + (size_t)(kt + 1) * (32 * LDP * 2) + kvoff + 32 * ks);
                }
                __builtin_amdgcn_sched_barrier(0);
                f32x16 acc = {0.f, 0.f, 0.f, 0.f, 0.f, 0.f, 0.f, 0.f, 0.f, 0.f, 0.f, 0.f, 0.f, 0.f, 0.f, 0.f};
#pragma unroll
                for (int ks = 0; ks < 4; ++ks) acc = __builtin_amdgcn_mfma_f32_32x32x16_bf16(af[ks], bq[kt & 1][ks], acc, 0, 0, 0);
                float s0 = 0.f, s1 = 0.f;
#pragma unroll
                for (int r = 0; r < 8; ++r) { s0 += wq[0][r] * __builtin_amdgcn_fmed3f(acc[r], 0.f, __builtin_inff()); s1 += wq[1][r] * __builtin_amdgcn_fmed3f(acc[8 + r], 0.f, __builtin_inff()); }
                const int sidx = 32 * kt + l32v; const unsigned low = 2047u - (unsigned)sidx;
                keys[kt][0] = (sidx <= t0q) ? ((ord_key(s0) & 0xFFFFF800u) | low) : 0u;
                keys[kt][1] = (sidx <= t0q + 1) ? ((ord_key(s1) & 0xFFFFF800u) | low) : 0u;
            } else { keys[kt][0] = 0u; keys[kt][1] = 0u; }
            __builtin_amdgcn_sched_barrier(0);
        }
        unsigned T0 = 0u, T1 = 0u; bool d0 = false, d1 = false;
#ifdef EXP_SELECT_ALL
        T0 = 1u; d0 = true; T1 = 1u; d1 = true;
#else
        if (t0q + 1 <= NSEL) { T0 = 1u; d0 = true; }
        if (t0q + 2 <= NSEL) { T1 = 1u; d1 = true; }
#endif
        for (int bit = 31; bit >= 0; --bit) {
            if (__all(d0 && d1)) break;
            const unsigned c0 = T0 | (1u << bit), c1 = T1 | (1u << bit);
            unsigned cnt = 0u;
#pragma unroll
            for (int gq = 0; gq < 4; ++gq)
                if (16 * gq < nktv) {
#pragma unroll
                    for (int k2 = 0; k2 < 16; ++k2) { cnt += (keys[16 * gq + k2][0] >= c0) ? 1u : 0u; cnt += (keys[16 * gq + k2][1] >= c1) ? 0x10000u : 0u; }
                }
#pragma unroll
            for (int o = 1; o < 32; o <<= 1) cnt += __shfl_xor(cnt, o);
            const unsigned n0 = cnt & 0xffffu, n1 = cnt >> 16;
            if (!d0) { if (n0 >= (unsigned)NSEL) T0 = c0; if (n0 == (unsigned)NSEL) d0 = true; }
            if (!d1) { if (n1 >= (unsigned)NSEL) T1 = c1; if (n1 == (unsigned)NSEL) d1 = true; }
        }
        const int qloc = 8 * w + 4 * tile + 2 * g;
#pragma unroll
        for (int kt = 0; kt < 64; ++kt)
            if (kt < nktv) {
                const unsigned long long b0 = __ballot(keys[kt][0] >= T0), b1 = __ballot(keys[kt][1] >= T1);
                if (l32 == 0) { maskL[(qloc + 0) * 64 + kt] = g ? (unsigned)(b0 >> 32) : (unsigned)b0; maskL[(qloc + 1) * 64 + kt] = g ? (unsigned)(b1 >> 32) : (unsigned)b1; }
            }
    }

#endif
#ifndef NO_PASS2
    {
        const int ql8 = l32 >> 2, hl = l32 & 3;
        const int tq = qw + ql8;
        const bf16* qrow = Pb + (size_t)tq * LDP + PC_Q + 8 * g;
        bf16x8 qf[2][4];
#pragma unroll
        for (int gk = 0; gk < 2; ++gk)
#pragma unroll
            for (int ks = 0; ks < 4; ++ks) qf[gk][ks] = *(const bf16x8*)(qrow + (4 * gk + hl) * 64 + 16 * ks);
        f32x16 O[2][2];
#pragma unroll
        for (int gk = 0; gk < 2; ++gk)
#pragma unroll
            for (int mt = 0; mt < 2; ++mt)
#pragma unroll
                for (int r = 0; r < 16; ++r) O[gk][mt][r] = 0.f;
        float lsum[2] = {0.f, 0.f}, mrun[2] = {0.f, 0.f};
        const float b31[2] = {tbl[hl * 128 + 127], tbl[(4 + hl) * 128 + 127]};
        const bf16* VTb = F.VT + (size_t)b * (2 * 64) * SEQ;
        const LAS unsigned* mrow = maskL + (8 * w + ql8) * 64;
        bool first = true;
        for (int kt = 0; kt < nkt; ++kt) {
            const unsigned mword = mrow[kt];
            if (__ballot(mword != 0u) == 0ull) continue;
            const unsigned mg = mword >> (4 * g);
            const bool far = (qw - (32 * kt + 31)) >= 113;
            const bf16* krow = Pb + (size_t)(32 * kt + l32) * LDP + PC_K + 8 * g;
#pragma unroll
            for (int gk = 0; gk < 2; ++gk) {
                f32x16 S = {0.f, 0.f, 0.f, 0.f, 0.f, 0.f, 0.f, 0.f, 0.f, 0.f, 0.f, 0.f, 0.f, 0.f, 0.f, 0.f};
#pragma unroll
                for (int ks = 0; ks < 4; ++ks) S = __builtin_amdgcn_mfma_f32_32x32x16_bf16(*(const bf16x8*)(krow + gk * 64 + 16 * ks), qf[gk][ks], S, 0, 0, 0);
                float x[16];
                if (far) { const float cb = b31[gk] - mrun[gk];
#pragma unroll
                    for (int r = 0; r < 16; ++r) x[r] = S[r] + cb;
                } else { const LAS float* tb = tbl + (4 * gk + hl) * 128; const int dbase = tq - 32 * kt - 4 * g; const float mr = mrun[gk];
#pragma unroll
                    for (int r = 0; r < 16; ++r) { int dd = dbase - ((r & 3) + 8 * (r >> 2)); dd = dd < 0 ? 0 : (dd > 127 ? 127 : dd); x[r] = S[r] + (tb[dd] - mr); }
                }
                float tm = x[0];
#pragma unroll
                for (int r = 1; r < 16; ++r) tm = fmaxf(tm, x[r]);
                tm = fmaxf(tm, __shfl_xor(tm, 32));
                if (first) { mrun[gk] = tm;
#pragma unroll
                    for (int r = 0; r < 16; ++r) x[r] -= tm;
                } else if (__any(tm > 8.f)) {
                    const float dl = fmaxf(tm, 0.f), alpha = __builtin_amdgcn_exp2f(-dl);
                    mrun[gk] += dl; lsum[gk] *= alpha;
#pragma unroll
                    for (int r = 0; r < 16; ++r) x[r] -= dl;
#pragma unroll
                    for (int mt = 0; mt < 2; ++mt)
#pragma unroll
                        for (int r = 0; r < 16; ++r) O[gk][mt][r] *= alpha;
                }
                float ps = 0.f; unsigned pk[8];
#pragma unroll
                for (int r = 0; r < 16; r += 2) {
                    const int bp0 = 8 * (r >> 2) + (r & 3), bp1 = 8 * ((r + 1) >> 2) + ((r + 1) & 3);
                    const unsigned sm0 = (unsigned)(((int)(mg << (31 - bp0))) >> 31), sm1 = (unsigned)(((int)(mg << (31 - bp1))) >> 31);
                    const float p0 = __uint_as_float(__float_as_uint(__builtin_amdgcn_exp2f(x[r])) & sm0), p1 = __uint_as_float(__float_as_uint(__builtin_amdgcn_exp2f(x[r + 1])) & sm1);
                    ps += p0 + p1; pk[r >> 1] = cvtpk(p0, p1);
                }
                lsum[gk] += ps;
                bf16x8 pf[2];
                { v4u t0 = {pk[0], pk[1], pk[2], pk[3]}, t1 = {pk[4], pk[5], pk[6], pk[7]}; pf[0] = __builtin_bit_cast(bf16x8, t0); pf[1] = __builtin_bit_cast(bf16x8, t1); }
#pragma unroll
                for (int mt = 0; mt < 2; ++mt)
#pragma unroll
                    for (int s = 0; s < 2; ++s) {
                        const bf16* vp = VTb + (size_t)(gk * 64 + 32 * mt + l32) * SEQ + 32 * kt + 16 * s + 4 * g;
                        const u32x2 lo = *(const u32x2*)vp, hi = *(const u32x2*)(vp + 8);
                        v4u vv = {lo.x, lo.y, hi.x, hi.y};
                        O[gk][mt] = __builtin_amdgcn_mfma_f32_32x32x16_bf16(__builtin_bit_cast(bf16x8, vv), pf[s], O[gk][mt], 0, 0, 0);
                    }
            }
            first = false;
        }
        bf16* orow = F.AR + (tok0 + tq) * LDAR;
#pragma unroll
        for (int gk = 0; gk < 2; ++gk) {
            const float lt = lsum[gk] + __shfl_xor(lsum[gk], 32), inv = 1.0f / lt;
#pragma unroll
            for (int mt = 0; mt < 2; ++mt)
#pragma unroll
                for (int i = 0; i < 4; ++i) { const int d = 32 * mt + 8 * i + 4 * g;
                    u32x2 wv; wv.x = cvtpk(O[gk][mt][4 * i] * inv, O[gk][mt][4 * i + 1] * inv); wv.y = cvtpk(O[gk][mt][4 * i + 2] * inv, O[gk][mt][4 * i + 3] * inv);
                    *(u32x2*)(orow + (4 * gk + hl) * 64 + d) = wv; }
        }
    }
#endif
}

constexpr int LRU_XCF = 0, LRU_ABF = 32768, LRU_ABF_STRIDE = 272, LRU_RAW = 51200, LRU_GY = 69632, LRU_OUT = 86016;
__device__ __forceinline__ void lru_unit(Frame& F, int b, int n) {
    const int tid = F.tid, lane = F.lane, w = F.wave, l16 = lane & 15, q = lane >> 4;
    LAS unsigned char* L = F.lds + RING_OFF;
    LAS float* XCF = (LAS float*)(L + LRU_XCF);
    LAS unsigned char* ABF = L + LRU_ABF;
    LAS bf16* RAW = (LAS bf16*)(L + LRU_RAW);
    LAS bf16* GY = (LAS bf16*)(L + LRU_GY);
    LAS bf16* OUTS = (LAS bf16*)(L + LRU_OUT);
    const size_t tok0 = (size_t)b * SEQ;
    const bf16* Pb = F.P + tok0 * LDP;
    const int ch0 = n * 128;
    bf16x8 brg[4], big[4];
    { const bf16* wr = F.Wrg_t + (size_t)n * 16384 + (16 * w + l16) * 128 + 8 * q; const bf16* wi = F.Wig_t + (size_t)n * 16384 + (16 * w + l16) * 128 + 8 * q;
#pragma unroll
      for (int ks = 0; ks < 4; ++ks) { brg[ks] = *(const bf16x8*)(wr + 32 * ks); big[ks] = *(const bf16x8*)(wi + 32 * ks); } }
    const int dch = ch0 + 16 * w + l16;
    const float brg_b = F.b_rg[dch], big_b = F.b_ig[dch];
    const float lam = F.lru_lambda[dch];
    const float sp = fmaxf(-lam, 0.f) + log1pf(expf(-fabsf(lam)));
    const float a_coef = -8.0f * sp;
    const int cc = tid & 127, tseg = tid >> 7;
    const float cw0 = F.conv_rnn_w[0 * D + ch0 + cc], cw1 = F.conv_rnn_w[1 * D + ch0 + cc], cw2 = F.conv_rnn_w[2 * D + ch0 + cc], cw3 = F.conv_rnn_w[3 * D + ch0 + cc], cbias = F.conv_rnn_b[ch0 + cc];
    float hprev = 0.f;
    v4u raw[3], gyr[2];
#define LRU_LOAD(t0_) do { _Pragma("unroll") for (int i_ = 0; i_ < 3; ++i_) { const int idx_ = tid + 512 * i_; raw[i_] = (v4u){0u, 0u, 0u, 0u}; \
            if (idx_ < 67 * 16) { const int row_ = idx_ >> 4, part_ = idx_ & 15, t_ = (t0_) - 3 + row_; if (t_ >= 0) raw[i_] = *(const v4u*)(Pb + (size_t)t_ * LDP + PC_XR + ch0 + 8 * part_); } } \
        _Pragma("unroll") for (int i_ = 0; i_ < 2; ++i_) { const int idx_ = tid + 512 * i_, row_ = idx_ >> 4, part_ = idx_ & 15; gyr[i_] = *(const v4u*)(Pb + (size_t)((t0_) + row_) * LDP + PC_YR + ch0 + 8 * part_); } } while (0)
    LRU_LOAD(0);
    for (int chunk = 0; chunk < SEQ / 64; ++chunk) {
        const int t0 = chunk * 64;
#pragma unroll
        for (int i = 0; i < 3; ++i) { const int idx = tid + 512 * i; if (idx < 67 * 16) *(LAS v4u*)(RAW + idx * 8) = raw[i]; }
#pragma unroll
        for (int i = 0; i < 2; ++i) { const int idx = tid + 512 * i; *(LAS v4u*)(GY + idx * 8) = gyr[i]; }
        __syncthreads();
        if (chunk + 1 < SEQ / 64) LRU_LOAD(t0 + 64);
        { float x0 = bf1(RAW[(16 * tseg + 0) * 128 + cc]), x1 = bf1(RAW[(16 * tseg + 1) * 128 + cc]), x2 = bf1(RAW[(16 * tseg + 2) * 128 + cc]);
#pragma unroll
          for (int tt = 0; tt < 16; ++tt) { const int t = 16 * tseg + tt; const float x3 = bf1(RAW[(t + 3) * 128 + cc]);
              const float xc = cbias + cw0 * x0 + cw1 * x1 + cw2 * x2 + cw3 * x3;
              XCF[t * 128 + cc] = xc; *(LAS bf16*)(ABF + t * LRU_ABF_STRIDE + cc * 2) = (bf16)f2bf(xc);
              x0 = x1; x1 = x2; x2 = x3; } }
        __syncthreads();
#pragma unroll 1
        for (int rt = 0; rt < 4; ++rt) {
            f32x4 accR = {0.f, 0.f, 0.f, 0.f}, accI = {0.f, 0.f, 0.f, 0.f};
            const LAS unsigned char* ap = ABF + (16 * rt + l16) * LRU_ABF_STRIDE + 16 * q;
#pragma unroll
            for (int ks = 0; ks < 4; ++ks) { const bf16x8 af = *(const LAS bf16x8*)(ap + 64 * ks);
                accR = __builtin_amdgcn_mfma_f32_16x16x32_bf16(af, brg[ks], accR, 0, 0, 0); accI = __builtin_amdgcn_mfma_f32_16x16x32_bf16(af, big[ks], accI, 0, 0, 0); }
            float Ap[4], Hl[4];
#pragma unroll
            for (int r = 0; r < 4; ++r) { const int tt = 16 * rt + 4 * q + r; const float xc = XCF[tt * 128 + 16 * w + l16];
                const float rr = sigmoidf_(accR[r] + brg_b), ii = sigmoidf_(accI[r] + big_b);
                const float la = a_coef * rr, a = expf(la), mult = sqrtf(-expm1f(2.0f * la)), u = xc * ii * mult;
                if (r == 0) { Ap[0] = a; Hl[0] = u; } else { Ap[r] = Ap[r - 1] * a; Hl[r] = a * Hl[r - 1] + u; } }
            float A = Ap[3], H = Hl[3];
            { const float Au = __shfl_up(A, 16), Hu = __shfl_up(H, 16); if (q >= 1) { H = A * Hu + H; A = A * Au; } }
            { const float Au = __shfl_up(A, 32), Hu = __shfl_up(H, 32); if (q >= 2) { H = A * Hu + H; A = A * Au; } }
            float Ae = __shfl_up(A, 16), He = __shfl_up(H, 16); if (q == 0) { Ae = 1.f; He = 0.f; }
            const float hin = He + Ae * hprev;
            const float A3 = __shfl(A, 48 + l16), H3 = __shfl(H, 48 + l16);
            hprev = H3 + A3 * hprev;
#pragma unroll
            for (int r = 0; r < 4; ++r) { const int tt = 16 * rt + 4 * q + r; const float h = Hl[r] + Ap[r] * hin; const float gv = bf1(GY[tt * 128 + 16 * w + l16]);
                OUTS[tt * 128 + 16 * w + l16] = (bf16)f2bf(h * gv); }
        }
        __syncthreads();
#pragma unroll
        for (int i = 0; i < 2; ++i) { const int idx = tid + 512 * i, row = idx >> 4, part = idx & 15;
            *(v4u*)(F.AR + (tok0 + t0 + row) * LDAR + 512 + ch0 + 8 * part) = *(const LAS v4u*)(OUTS + idx * 8); }
    }
#undef LRU_LOAD
}

__device__ __forceinline__ void p3_mixers(Frame& F) {
    { LAS float* tbl = (LAS float*)(F.lds + RING_OFF + ATT_TBL_OFF);
      for (int i = F.tid; i < 8 * 128; i += NWAVES * 64) { const int h = i >> 7, d = i & 127; tbl[i] = F.rel_bias[(int)T5_BUCKET[d] * NH + h] * LOG2E; } }
    __syncthreads();
    for (int e = F.vcu; e < 1024; e += F.G) {
        const int k = e >> 8, r = e & 255, b = r >> 3, j = r & 7;
        const int qb = (k == 0) ? 31 - j : (k == 1) ? 16 + j : (k == 2) ? 15 - j : j;
#ifndef NO_ATT
        attn_unit(F, b, qb);
#else
        for (int i = F.tid; i < 64 * 64; i += NWAVES * 64) { const int row = i >> 6, part = i & 63; *(v4u*)(F.AR + ((size_t)b * SEQ + qb * 64 + row) * LDAR + 8 * part) = (v4u){0u, 0u, 0u, 0u}; }
#endif
    }
    __syncthreads();
#ifndef NO_LRU
    for (int u = F.vcu; u < BATCH * 8; u += F.G) lru_unit(F, u >> 3, u & 7);
#else
    for (int u = F.vcu; u < BATCH * 8; u += F.G) { const int b = u >> 3, n = u & 7;
        for (int i = F.tid; i < SEQ * 16; i += NWAVES * 64) { const int row = i >> 4, part = i & 15; *(v4u*)(F.AR + ((size_t)b * SEQ + row) * LDAR + 512 + n * 128 + 8 * part) = (v4u){0u, 0u, 0u, 0u}; } }
#endif
}

#ifndef MK_N_LAUNCHES
#define MK_N_LAUNCHES 1
#endif
constexpr int N_PHASES = 14;

#define CAS __attribute__((address_space(4)))
__device__ __forceinline__ void frame_ptrs(Frame& F) {
    const CAS unsigned long long* kp = (const CAS unsigned long long*)__builtin_amdgcn_kernarg_segment_ptr();
    asm volatile("" : "+s"(kp));
    { int t_ = threadIdx.x; asm volatile("" : "+v"(t_)); F.tid = t_; F.lane = t_ & 63; }
#define KIN(k) ((const float*)(const GAS float*)kp[k])
    F.x = KIN(0); F.c = KIN(1); F.w_ada = KIN(2); F.b_ada = KIN(3); F.g_mix = KIN(4); F.w_in = KIN(5); F.b_in = KIN(6); F.rel_bias = KIN(7);
    F.conv_rnn_w = KIN(8); F.conv_rnn_b = KIN(9); F.w_rg = KIN(10); F.b_rg = KIN(11); F.w_ig = KIN(12); F.b_ig = KIN(13); F.lru_lambda = KIN(14);
    F.w_o_attn = KIN(15); F.w_o_rnn = KIN(16); F.w_out = KIN(17); F.g_ffn = KIN(18); F.w_up = KIN(19); F.conv_ffn_w = KIN(20); F.conv_ffn_b = KIN(21);
    F.w_down = KIN(22); F.g_final = KIN(23);
#undef KIN
    F.out = (float*)(GAS float*)kp[24];
    GAS unsigned char* ws = (GAS unsigned char*)kp[25];
    F.mod = (float*)(ws + WS_MOD); F.biasp = (float*)(ws + WS_BIASP);
    F.Win_t = (bf16*)(ws + WS_WIN); F.Wup_t = (bf16*)(ws + WS_WUP); F.Wdn_t = (bf16*)(ws + WS_WDN); F.Woa_t = (bf16*)(ws + WS_WOA); F.Wor_t = (bf16*)(ws + WS_WOR); F.Wout_t = (bf16*)(ws + WS_WOUT);
    F.Wrg_t = (bf16*)(ws + WS_WRG); F.Wig_t = (bf16*)(ws + WS_WIG);
    F.VT = (bf16*)(ws + WS_VT); F.P = (bf16*)(ws + WS_A); F.UPH = (bf16*)(ws + WS_A); F.ACT = (bf16*)(ws + WS_ACT); F.XN = (bf16*)(ws + WS_B); F.T1 = (bf16*)(ws + WS_B); F.MG = (bf16*)(ws + WS_C);
    F.AR = (bf16*)(GAS bf16*)kp[24];
}
struct Args { const float* in[24]; float* out; unsigned char* ws; int ph_lo, ph_hi; };
__global__ void __launch_bounds__(NWAVES * 64, 2) mk_fwd(Args args) {
    extern __shared__ __attribute__((aligned(16))) unsigned char lds[];
    Frame F;
    F.lds = (LAS unsigned char*)lds;
    F.MISC = (volatile LAS unsigned*)(F.lds + MISC_OFF);
    F.tid = threadIdx.x; F.lane = F.tid & 63; F.wave = __builtin_amdgcn_readfirstlane(F.tid >> 6);
    F.G = gridDim.x; { const int bx = blockIdx.x; F.vcu = (F.G % 8 == 0) ? (bx % 8) * (F.G / 8) + bx / 8 : bx; }
    F.ctl = (gu32*)(args.ws + WS_CTL);
    for (int u = F.tid; u < (LDS_BYTES - LDSCTL_OFF) / 4; u += NWAVES * 64) ((LAS unsigned*)(F.lds + LDSCTL_OFF))[u] = 0u;
    __syncthreads();
    const int lo = args.ph_lo, hi = args.ph_hi;
    XcdBarrier bar; bar.bar = (unsigned*)(F.ctl + CW_BAR); bar.x = 0; bar.st = nullptr;
    if (hi - lo > 1) bar = xcd_barrier_post((unsigned*)(F.ctl + CW_BAR), F.MISC + 8);
#ifndef PHASE_MASK
#define PHASE_MASK 0xFFFFu
#endif
#define IN(k) (((PHASE_MASK >> (k)) & 1u) && lo <= (k) && (k) < hi)
#define SEAM(k) do { if (IN(k) && IN((k) + 1)) xcd_barrier(bar); } while (0)
    typedef pg8::bf16_t gb;

    if (IN(0)) { frame_ptrs(F); p0_prologue(F); } SEAM(0);
    if (IN(1)) { frame_ptrs(F); p_norm_mod(F, F.x, F.XN, F.g_mix, 0 * D, 1 * D); } SEAM(1);
    if (IN(2)) { frame_ptrs(F);
        pg8::Gemm g{(const gb*)F.XN, (const gb*)F.Win_t, M, LDP, D, D, D}; pg8::StaticOrder S; S.init(M, LDP, F.G, (int)blockIdx.x);
        pg8::EpiProj E{(gb*)F.P, LDP, F.biasp, (gb*)F.VT, SEQ, QSCALE};
        pg8::gemm_phase<pg8::EpiProj, pg8::StaticOrder, true, true>(F.lds + RING_OFF, g, S, E);
    } SEAM(2);
    if (IN(3)) { frame_ptrs(F); p3_mixers(F); } SEAM(3);
    if (IN(4)) { frame_ptrs(F);
        pg8::Gemm g{(const gb*)F.AR, (const gb*)F.Woa_t, M, D, 512, LDAR, 512}; pg8::StaticOrder S; S.init(M, D, F.G, (int)blockIdx.x);
        pg8::EpiGate<false> E{(const gb*)F.P + PC_GA, LDP, nullptr, (gb*)F.T1, D};
        pg8::gemm_phase<pg8::EpiGate<false>, pg8::StaticOrder, true, true>(F.lds + RING_OFF, g, S, E);
    } SEAM(4);
    if (IN(5)) { frame_ptrs(F);
        pg8::Gemm g{(const gb*)F.AR + 512, (const gb*)F.Wor_t, M, D, D, LDAR, D}; pg8::StaticOrder S; S.init(M, D, F.G, (int)blockIdx.x);
        pg8::EpiGate<true> E{(const gb*)F.P + PC_GB, LDP, (const gb*)F.T1, (gb*)F.MG, D};
        pg8::gemm_phase<pg8::EpiGate<true>, pg8::StaticOrder, true, true>(F.lds + RING_OFF, g, S, E);
    } SEAM(5);
    if (IN(6)) { frame_ptrs(F);
        pg8::Gemm g{(const gb*)F.MG, (const gb*)F.Wout_t, M, D, D, D, D}; pg8::StaticOrder S; S.init(M, D, F.G, (int)blockIdx.x);
        pg8::EpiResid E{F.x, F.out, D, F.mod + 2 * D, NMOD, SEQ};
        pg8::gemm_phase<pg8::EpiResid, pg8::StaticOrder, true, true>(F.lds + RING_OFF, g, S, E);
    } SEAM(6);
    if (IN(7)) { frame_ptrs(F); p_norm_mod(F, F.out, F.XN, F.g_ffn, 3 * D, 4 * D); } SEAM(7);
    if (IN(8)) { frame_ptrs(F);
        pg8::Gemm g{(const gb*)F.XN, (const gb*)F.Wup_t, M, DFF, D, D, D}; pg8::StaticOrder S; S.init(M, DFF, F.G, (int)blockIdx.x);
        pg8::EpiBf16Plain E{(gb*)F.UPH, DFF};
        pg8::gemm_phase<pg8::EpiBf16Plain, pg8::StaticOrder, true, true>(F.lds + RING_OFF, g, S, E);
    } SEAM(8);
    if (IN(9)) { frame_ptrs(F); p_act(F, 0); } SEAM(9);
    if (IN(10)) { frame_ptrs(F);
        pg8::Gemm g{(const gb*)F.XN, (const gb*)F.Wup_t + (size_t)DFF * D, M, DFF, D, D, D}; pg8::StaticOrder S; S.init(M, DFF, F.G, (int)blockIdx.x);
        pg8::EpiBf16Plain E{(gb*)F.UPH, DFF};
        pg8::gemm_phase<pg8::EpiBf16Plain, pg8::StaticOrder, true, true>(F.lds + RING_OFF, g, S, E);
    } SEAM(10);
    if (IN(11)) { frame_ptrs(F); p_act(F, 1); } SEAM(11);
    if (IN(12)) { frame_ptrs(F);
        pg8::Gemm g{(const gb*)F.ACT, (const gb*)F.Wdn_t, M, D, DFF, DFF, DFF}; pg8::StaticOrder S; S.init(M, D, F.G, (int)blockIdx.x);
        pg8::EpiResid E{F.out, F.out, D, F.mod + 5 * D, NMOD, SEQ};
        pg8::gemm_phase<pg8::EpiResid, pg8::StaticOrder, true, true>(F.lds + RING_OFF, g, S, E);
    } SEAM(12);
    if (IN(13)) { frame_ptrs(F); p_norm_final(F); }
#undef IN
#undef SEAM
}

extern "C" void kernel_launch(void* const* d_in, const int* in_sizes, int n_in, void* d_out, int out_size, void* d_ws, size_t ws_size, hipStream_t stream) {
    static int grid = 0;
    if (grid == 0) {
        if (n_in != 24 || in_sizes[0] != M * D || out_size != M * D || ws_size < WS_END) { fprintf(stderr, "kernel_launch: unexpected shapes (n_in %d, in0 %d, out %d, ws %zu); nothing launched\n", n_in, n_in > 0 ? in_sizes[0] : -1, out_size, ws_size); grid = -1; return; }
        int dev = 0, cus = 0, per_cu = 0;
        if (hipGetDevice(&dev) != hipSuccess || hipDeviceGetAttribute(&cus, hipDeviceAttributeMultiprocessorCount, dev) != hipSuccess) { grid = -1; return; }
        if (hipFuncSetAttribute((const void*)mk_fwd, hipFuncAttributeMaxDynamicSharedMemorySize, LDS_BYTES) != hipSuccess) { fprintf(stderr, "kernel_launch: hipFuncSetAttribute failed\n"); grid = -1; return; }
        if (hipOccupancyMaxActiveBlocksPerMultiprocessor(&per_cu, (const void*)mk_fwd, NWAVES * 64, LDS_BYTES) != hipSuccess || per_cu < 1) { fprintf(stderr, "kernel_launch: occupancy query reports %d blocks per CU\n", per_cu); }
        (void)hipGetLastError();
        grid = cus;
    }
    if (grid < 0) return;
    if (hipMemsetAsync((char*)d_ws + WS_CTL, 0, CTL_ZERO_BYTES, stream) != hipSuccess) { fprintf(stderr, "kernel_launch: memset failed\n"); return; }
    Args a{};
    for (int i = 0; i < 24; ++i) a.in[i] = (const float*)d_in[i];
    a.out = (float*)d_out; a.ws = (unsigned char*)d_ws;
#if MK_N_LAUNCHES == 1
    a.ph_lo = 0; a.ph_hi = N_PHASES;
    hipLaunchKernelGGL(mk_fwd, dim3(grid), dim3(NWAVES * 64), LDS_BYTES, stream, a);
#else
    for (int p = 0; p < N_PHASES; ++p) { a.ph_lo = p; a.ph_hi = p + 1; hipLaunchKernelGGL(mk_fwd, dim3(grid), dim3(NWAVES * 64), LDS_BYTES, stream, a); }
#endif
    const hipError_t le = hipPeekAtLastError();
    if (le != hipSuccess) fprintf(stderr, "kernel_launch: launch failed: %s\n", hipGetErrorName(le));
}
```

```cpp
#define MK_N_LAUNCHES 1
#include <hip/hip_runtime.h>
#include <cstdio>
#include <cstdint>
namespace pg8 {
#define PG8_LAS __attribute__((address_space(3)))
typedef unsigned short bf16_t;
typedef short bf16x8 __attribute__((ext_vector_type(8)));
typedef float f32x4 __attribute__((ext_vector_type(4)));
typedef unsigned u32x4 __attribute__((ext_vector_type(4)));
constexpr int BM = 256, BK = 64, HALF = 128, HTB = HALF * BK * 2  , STAGE_BYTES = 8 * HTB, NXCD = 8, WGM = 8;

__host__ __device__ __forceinline__ int lds_byte(int r, int c) { const int st = (r >> 4) * 2 + (c >> 5), rr = r & 15, cc = c & 31, ob = rr * 64 + cc * 2; return st * 1024 + (ob ^ (((ob >> 9) & 1) << 5)); }
__host__ __device__ __forceinline__ void stage_rc(int b, int& R, int& C) { const int st = b / 1024, sb = b % 1024, swz = sb ^ (((sb >> 9) & 1) << 5); R = (st >> 1) * 16 + swz / 64; C = (st & 1) * 32 + (swz % 64) / 2; }
__host__ __device__ __forceinline__ int perm32(int rho) { const int n = rho >> 4, i = rho & 15; return 8 * (i >> 2) + 4 * n + (i & 3); }

struct Unit { int pm, pn; };
struct Gemm { const bf16_t* A; const bf16_t* Bt; int M, N, K, lda, ldb; };

struct StaticOrder {
    int nM, nN, nwg, G, c;
    __host__ __device__ void init(int M, int N, int G_, int c_) { nM = M / BM; nN = N / BM; nwg = nM * nN; G = G_; c = c_; }
    __host__ __device__ bool next(int i, Unit& u) const {
        const long L = (long)i * G + c; if (L >= nwg) return false;
        int wgid = (int)L; { const int q = nwg / NXCD, r = nwg % NXCD, xcd = wgid % NXCD, off = wgid / NXCD; wgid = (xcd < r ? xcd * (q + 1) : r * (q + 1) + (xcd - r) * q) + off; }
        const int nig = WGM * nN, gid = wgid / nig, fm = gid * WGM, gsz = (nM - fm) < WGM ? (nM - fm) : WGM;
        u.pm = fm + ((wgid % nig) % gsz); u.pn = (wgid % nig) / gsz; return true;
    }
    __device__ __forceinline__ void a_ready(const Unit&) const {}
    __device__ __forceinline__ void done(const Unit&) const {}
};

typedef float f32x2 __attribute__((ext_vector_type(2))); typedef __bf16 bf16x2v __attribute__((ext_vector_type(2)));
__device__ __forceinline__ unsigned cvt_pk_bf16(float lo, float hi) { f32x2 v = {lo, hi}; bf16x2v b = __builtin_convertvector(v, bf16x2v); return __builtin_bit_cast(unsigned, b); }
typedef unsigned u32x2 __attribute__((ext_vector_type(2)));
__device__ __forceinline__ float bf_lo(unsigned u) { return __uint_as_float(u << 16); }
__device__ __forceinline__ float bf_hi(unsigned u) { return __uint_as_float(u & 0xffff0000u); }
__device__ __forceinline__ float fast_sigmoid(float x) { return __builtin_amdgcn_rcpf(1.f + __builtin_amdgcn_exp2f(-1.4426950408889634f * x)); }
__device__ __forceinline__ float gelu_tanh(float x) { const float z = 1.5957691216057308f * x * (1.f + 0.044715f * x * x); return x * fast_sigmoid(z); }

struct EpiBf16Plain {
    static constexpr bool PERM = true, AFTER_DRAIN = false;
    bf16_t* O; int ldc;
    __device__ __forceinline__ void operator()(const f32x4 (&acc)[2][2][4][2], const Unit& u, int wr, int wc, int fr, int fq) const {
        const int row0 = u.pm * BM + wr * 64 + fr, col0 = u.pn * BM + wc * 32 + 8 * fq;
#pragma unroll
        for (int ai = 0; ai < 2; ++ai)
#pragma unroll
            for (int m = 0; m < 4; ++m) { bf16_t* rowp = O + (size_t)(row0 + ai * HALF + m * 16) * ldc + col0;
#pragma unroll
                for (int bj = 0; bj < 2; ++bj) { const f32x4 v0 = acc[ai][bj][m][0], v1 = acc[ai][bj][m][1];
                    u32x4 w; w.x = cvt_pk_bf16(v0[0], v0[1]); w.y = cvt_pk_bf16(v0[2], v0[3]); w.z = cvt_pk_bf16(v1[0], v1[1]); w.w = cvt_pk_bf16(v1[2], v1[3]);
                    *(u32x4*)(rowp + bj * HALF) = w; } }
    }
};

struct EpiProj {
    static constexpr bool PERM = true, AFTER_DRAIN = false;
    bf16_t* P; int ldp; const float* bias; bf16_t* VT; int seq; float c2;
    template <int KIND> __device__ __forceinline__ void run(const f32x4 (&acc)[2][2][4][2], const Unit& u, int wr, int wc, int fr, int fq) const {
        const int row0 = u.pm * BM + wr * 64 + fr, col0 = u.pn * BM + wc * 32 + 8 * fq;
        f32x4 bv[2][2];
#pragma unroll
        for (int bj = 0; bj < 2; ++bj)
#pragma unroll
            for (int n = 0; n < 2; ++n) bv[bj][n] = *(const f32x4*)(bias + col0 + bj * HALF + 4 * n);
#pragma unroll
        for (int ai = 0; ai < 2; ++ai)
#pragma unroll
            for (int m = 0; m < 4; ++m) { const int row = row0 + ai * HALF + m * 16; bf16_t* rowp = P + (size_t)row * ldp + col0;
#pragma unroll
                for (int bj = 0; bj < 2; ++bj) { f32x4 v0 = acc[ai][bj][m][0] + bv[bj][0], v1 = acc[ai][bj][m][1] + bv[bj][1];
                    if (KIND == 0) { v0 = v0 * c2; v1 = v1 * c2; }
                    if (KIND == 3) { v0 = (f32x4){gelu_tanh(v0[0]), gelu_tanh(v0[1]), gelu_tanh(v0[2]), gelu_tanh(v0[3])}; v1 = (f32x4){gelu_tanh(v1[0]), gelu_tanh(v1[1]), gelu_tanh(v1[2]), gelu_tanh(v1[3])}; }
                    if (KIND == 4) { v0 = (f32x4){fast_sigmoid(v0[0]), fast_sigmoid(v0[1]), fast_sigmoid(v0[2]), fast_sigmoid(v0[3])}; v1 = (f32x4){fast_sigmoid(v1[0]), fast_sigmoid(v1[1]), fast_sigmoid(v1[2]), fast_sigmoid(v1[3])}; }
                    u32x4 w; w.x = cvt_pk_bf16(v0[0], v0[1]); w.y = cvt_pk_bf16(v0[2], v0[3]); w.z = cvt_pk_bf16(v1[0], v1[1]); w.w = cvt_pk_bf16(v1[2], v1[3]);
                    *(u32x4*)(rowp + bj * HALF) = w;
                    if (KIND == 1 && bj == 1) {
                        const int b = row / seq, s = row - b * seq, dv0 = wc * 32 + 8 * fq;
                        bf16_t* vt = VT + ((size_t)(b * 2 + (dv0 >> 6)) * 64 + (dv0 & 63)) * seq + s;
                        vt[0 * (size_t)seq] = (bf16_t)(w.x & 0xffffu); vt[1 * (size_t)seq] = (bf16_t)(w.x >> 16);
                        vt[2 * (size_t)seq] = (bf16_t)(w.y & 0xffffu); vt[3 * (size_t)seq] = (bf16_t)(w.y >> 16);
                        vt[4 * (size_t)seq] = (bf16_t)(w.z & 0xffffu); vt[5 * (size_t)seq] = (bf16_t)(w.z >> 16);
                        vt[6 * (size_t)seq] = (bf16_t)(w.w & 0xffffu); vt[7 * (size_t)seq] = (bf16_t)(w.w >> 16);
                    } } }
    }
    __device__ __forceinline__ void operator()(const f32x4 (&acc)[2][2][4][2], const Unit& u, int wr, int wc, int fr, int fq) const {
        const int pn = u.pn;
        if (pn < 2) run<0>(acc, u, wr, wc, fr, fq);
        else if (pn == 2) run<1>(acc, u, wr, wc, fr, fq);
        else if (pn < 10) run<2>(acc, u, wr, wc, fr, fq);
        else if (pn < 14) run<3>(acc, u, wr, wc, fr, fq);
        else run<4>(acc, u, wr, wc, fr, fq);
    }
};

template <bool ADD> struct EpiGate {
    static constexpr bool PERM = true, AFTER_DRAIN = false;
    const bf16_t* G; int ldg; const bf16_t* base; bf16_t* O; int ldc;
    __device__ __forceinline__ void operator()(const f32x4 (&acc)[2][2][4][2], const Unit& u, int wr, int wc, int fr, int fq) const {
        const int row0 = u.pm * BM + wr * 64 + fr, col0 = u.pn * BM + wc * 32 + 8 * fq;
#pragma unroll
        for (int ai = 0; ai < 2; ++ai)
#pragma unroll
            for (int m = 0; m < 4; ++m) { const size_t row = (size_t)(row0 + ai * HALF + m * 16);
#pragma unroll
                for (int bj = 0; bj < 2; ++bj) { const int col = col0 + bj * HALF;
                    const u32x4 gq = *(const u32x4*)(G + row * ldg + col);
                    f32x4 v0 = acc[ai][bj][m][0], v1 = acc[ai][bj][m][1];
                    v0 = v0 * (f32x4){bf_lo(gq.x), bf_hi(gq.x), bf_lo(gq.y), bf_hi(gq.y)}; v1 = v1 * (f32x4){bf_lo(gq.z), bf_hi(gq.z), bf_lo(gq.w), bf_hi(gq.w)};
                    if (ADD) { const u32x4 bq = *(const u32x4*)(base + row * ldc + col);
                        v0 = v0 + (f32x4){bf_lo(bq.x), bf_hi(bq.x), bf_lo(bq.y), bf_hi(bq.y)}; v1 = v1 + (f32x4){bf_lo(bq.z), bf_hi(bq.z), bf_lo(bq.w), bf_hi(bq.w)}; }
                    u32x4 w; w.x = cvt_pk_bf16(v0[0], v0[1]); w.y = cvt_pk_bf16(v0[2], v0[3]); w.z = cvt_pk_bf16(v1[0], v1[1]); w.w = cvt_pk_bf16(v1[2], v1[3]);
                    *(u32x4*)(O + row * ldc + col) = w; } }
    }
};

struct EpiResid {
    static constexpr bool PERM = false, AFTER_DRAIN = false;
    const float* base; float* out; int ldc; const float* gvec; int gstride; int seq;
    __device__ __forceinline__ void operator()(const f32x4 (&acc)[2][2][4][2], const Unit& u, int wr, int wc, int fr, int fq) const {
        const int row0 = u.pm * BM + wr * 64 + fr, col0 = u.pn * BM + wc * 32 + 4 * fq;
        const float* gv = gvec + (size_t)((u.pm * BM) / seq) * gstride;
        f32x4 g4[2][2];
#pragma unroll
        for (int bj = 0; bj < 2; ++bj)
#pragma unroll
            for (int n = 0; n < 2; ++n) g4[bj][n] = *(const f32x4*)(gv + col0 + bj * HALF + n * 16);
#pragma unroll
        for (int ai = 0; ai < 2; ++ai)
#pragma unroll
            for (int m = 0; m < 4; ++m) { const size_t off = (size_t)(row0 + ai * HALF + m * 16) * ldc + col0;
#pragma unroll
                for (int bj = 0; bj < 2; ++bj)
#pragma unroll
                    for (int n = 0; n < 2; ++n) { const f32x4 bs = *(const f32x4*)(base + off + bj * HALF + n * 16);
                        *(f32x4*)(out + off + bj * HALF + n * 16) = bs + g4[bj][n] * acc[ai][bj][m][n]; }
                if (m & 1) asm volatile("" ::: "memory"); }
    }
};

template <class Epi, class Sched, bool ALIGN_EPI = false, bool SP2 = false>
__device__ __forceinline__ void gemm_phase(PG8_LAS unsigned char* lds, const Gemm g, const Sched& S, const Epi& E) {
    const int tid = threadIdx.x, wid = __builtin_amdgcn_readfirstlane(tid >> 6), lane = tid & 63, wr = wid >> 2, wc = wid & 3, fr = lane & 15, fq = lane >> 4;
    const int K = g.K, nt = K / BK;
    unsigned voffA[2], voffB[2];
#pragma unroll
    for (int i = 0; i < 2; ++i) { int R, C; stage_rc(tid * 16 + i * 8192, R, C); const int Rb = Epi::PERM ? ((R & ~31) + perm32(R & 31)) : R;
        voffA[i] = (unsigned)(R * g.lda + C) * 2u; voffB[i] = (unsigned)(Rb * g.ldb + C) * 2u; }
    const size_t kstep = (size_t)(BK * 2);
    const size_t hstepA = (size_t)HALF * g.lda * 2, hstepB = (size_t)HALF * g.ldb * 2;
    const size_t tstepA = 2 * hstepA, tstepB = 2 * hstepB;
    const unsigned ldsw = (unsigned)wid * 1024u;
    const int aoff = lds_byte(wr * 64 + fr, fq * 8), boff = lds_byte(wc * 32 + fr, fq * 8);
#define PG8_SA(b, h) (((b) * 2 + (h)) * HTB)
#define PG8_SB(b, h) ((4 + (b) * 2 + (h)) * HTB)
#define PG8_STAGE(bufoff, gbase, voff) do { _Pragma("unroll") for (int _i = 0; _i < 2; ++_i) \
        __builtin_amdgcn_global_load_lds((const unsigned*)((const char*)(gbase) + (voff)[_i]), (PG8_LAS unsigned*)(lds + (bufoff) + ldsw + _i * 8192), 16, 0, 0); } while (0)
#define PG8_LDA(dst, b, h) do { _Pragma("unroll") for (int m = 0; m < 4; ++m) _Pragma("unroll") for (int k = 0; k < 2; ++k) dst[m][k] = *(const PG8_LAS bf16x8*)(lds + PG8_SA(b, h) + aoff + m * 2048 + k * 1024); } while (0)
#define PG8_LDB(dst, b, h) do { _Pragma("unroll") for (int n = 0; n < 2; ++n) _Pragma("unroll") for (int k = 0; k < 2; ++k) dst[n][k] = *(const PG8_LAS bf16x8*)(lds + PG8_SB(b, h) + boff + n * 2048 + k * 1024); } while (0)
#define PG8_MMA(ai, bj, At, Bt) do { __builtin_amdgcn_s_setprio(1); _Pragma("unroll") for (int m = 0; m < 4; ++m) _Pragma("unroll") for (int n = 0; n < 2; ++n) _Pragma("unroll") for (int k = 0; k < 2; ++k) \
        acc[ai][bj][m][n] = __builtin_amdgcn_mfma_f32_16x16x32_bf16(Bt[n][k], At[m][k], acc[ai][bj][m][n], 0, 0, 0); __builtin_amdgcn_s_setprio(0); } while (0)
#define PG8_WAIT_V(n) asm volatile("s_waitcnt vmcnt(" #n ")" ::: "memory")
#define PG8_WAIT_L(n) asm volatile("s_waitcnt lgkmcnt(" #n ")" ::: "memory")
#define PG8_BAR __builtin_amdgcn_s_barrier()
#define PG8_SCHED __builtin_amdgcn_sched_barrier(0)
    Unit cur, nxt; int ui = 0;
    if (!S.next(0, cur)) return;
    f32x4 acc[2][2][4][2];
#pragma unroll
    for (int a = 0; a < 2; ++a)
#pragma unroll
        for (int b = 0; b < 2; ++b)
#pragma unroll
            for (int m = 0; m < 4; ++m)
#pragma unroll
                for (int n = 0; n < 2; ++n) acc[a][b][m][n] = (f32x4){0.f, 0.f, 0.f, 0.f};
    bf16x8 At[4][2], B0[2][2], B1[2][2];
    const char* cA = (const char*)g.A + (size_t)cur.pm * tstepA; const char* cB = (const char*)g.Bt + (size_t)cur.pn * tstepB;
    S.a_ready(cur);
    if constexpr (SP2) {
        PG8_STAGE(PG8_SB(0, 0), cB, voffB); PG8_STAGE(PG8_SB(0, 1), cB + hstepB, voffB); PG8_STAGE(PG8_SA(0, 0), cA, voffA); PG8_STAGE(PG8_SA(0, 1), cA + hstepA, voffA);
        if (wr == 1) PG8_BAR;
        PG8_WAIT_V(2); PG8_BAR;
        PG8_STAGE(PG8_SB(1, 0), cB + kstep, voffB); PG8_STAGE(PG8_SA(1, 0), cA + kstep, voffA); PG8_STAGE(PG8_SB(1, 1), cB + hstepB + kstep, voffB);
        PG8_WAIT_V(6); PG8_BAR;
    } else {
        PG8_STAGE(PG8_SB(0, 0), cB, voffB); PG8_STAGE(PG8_SA(0, 0), cA, voffA); PG8_STAGE(PG8_SB(0, 1), cB + hstepB, voffB); PG8_STAGE(PG8_SA(0, 1), cA + hstepA, voffA);
        if (wr == 1) PG8_BAR;
        PG8_WAIT_V(4); PG8_BAR;
        PG8_STAGE(PG8_SB(1, 0), cB + kstep, voffB); PG8_STAGE(PG8_SA(1, 0), cA + kstep, voffA); PG8_STAGE(PG8_SB(1, 1), cB + hstepB + kstep, voffB);
        PG8_WAIT_V(6); PG8_BAR;
    }
    for (;;) {
        const bool has_next = S.next(ui + 1, nxt);
        const char* nA = has_next ? (const char*)g.A + (size_t)nxt.pm * tstepA : cA; const char* nB = has_next ? (const char*)g.Bt + (size_t)nxt.pn * tstepB : cB;
        for (int t = 0; t < nt; t += 2) {
            const bool last = (t == nt - 2);
            const char* a1 = cA + (size_t)(t + 1) * kstep;
            const char* a2 = last ? nA : cA + (size_t)(t + 2) * kstep; const char* b2 = last ? nB : cB + (size_t)(t + 2) * kstep;
            const char* a3 = a2 + kstep; const char* b3 = b2 + kstep;
            if (last && has_next) S.a_ready(nxt);
            if constexpr (SP2) {
            PG8_LDB(B0, 0, 0); PG8_LDB(B1, 0, 1); PG8_SCHED; PG8_LDA(At, 0, 0); PG8_STAGE(PG8_SA(1, 1), a1 + hstepA, voffA);
            PG8_WAIT_V(8); PG8_WAIT_L(0); PG8_BAR; PG8_MMA(0, 0, At, B0); PG8_MMA(0, 1, At, B1); PG8_BAR; PG8_SCHED;
            PG8_LDA(At, 0, 1); PG8_STAGE(PG8_SB(0, 0), b2, voffB); PG8_STAGE(PG8_SB(0, 1), b2 + hstepB, voffB); PG8_STAGE(PG8_SA(0, 0), a2, voffA);
            PG8_WAIT_V(8); PG8_WAIT_L(0); PG8_BAR; PG8_MMA(1, 0, At, B0); PG8_MMA(1, 1, At, B1); PG8_BAR; PG8_SCHED;
            PG8_LDB(B0, 1, 0); PG8_LDB(B1, 1, 1); PG8_SCHED; PG8_LDA(At, 1, 0); PG8_STAGE(PG8_SA(0, 1), a2 + hstepA, voffA);
            PG8_WAIT_V(8); PG8_WAIT_L(0); PG8_BAR; PG8_MMA(0, 0, At, B0); PG8_MMA(0, 1, At, B1); PG8_BAR; PG8_SCHED;
            PG8_LDA(At, 1, 1); PG8_STAGE(PG8_SB(1, 0), b3, voffB); PG8_STAGE(PG8_SB(1, 1), b3 + hstepB, voffB); PG8_STAGE(PG8_SA(1, 0), a3, voffA);
            PG8_WAIT_V(8); PG8_WAIT_L(0); PG8_BAR; PG8_MMA(1, 0, At, B0); PG8_MMA(1, 1, At, B1); PG8_BAR; PG8_SCHED;
            } else {
            PG8_LDB(B0, 0, 0); PG8_SCHED; PG8_LDA(At, 0, 0); PG8_STAGE(PG8_SA(1, 1), a1 + hstepA, voffA);
            PG8_WAIT_L(8); PG8_BAR; PG8_WAIT_L(0); PG8_MMA(0, 0, At, B0); PG8_BAR; PG8_SCHED;
            PG8_LDB(B1, 0, 1); PG8_STAGE(PG8_SB(0, 0), b2, voffB);
            PG8_BAR; PG8_WAIT_L(0); PG8_MMA(0, 1, At, B1); PG8_BAR;
            PG8_LDA(At, 0, 1); PG8_STAGE(PG8_SA(0, 0), a2, voffA);
            PG8_BAR; PG8_WAIT_L(0); PG8_MMA(1, 0, At, B0); PG8_BAR; PG8_SCHED;
            PG8_STAGE(PG8_SB(0, 1), b2 + hstepB, voffB);
            PG8_WAIT_V(6); PG8_BAR; PG8_MMA(1, 1, At, B1); PG8_BAR;
            PG8_LDB(B0, 1, 0); PG8_SCHED; PG8_LDA(At, 1, 0); PG8_STAGE(PG8_SA(0, 1), a2 + hstepA, voffA);
            PG8_WAIT_L(8); PG8_BAR; PG8_WAIT_L(0); PG8_MMA(0, 0, At, B0); PG8_BAR; PG8_SCHED;
            PG8_LDB(B1, 1, 1); PG8_STAGE(PG8_SB(1, 0), b3, voffB);
            PG8_BAR; PG8_WAIT_L(0); PG8_MMA(0, 1, At, B1); PG8_BAR;
            PG8_LDA(At, 1, 1); PG8_STAGE(PG8_SA(1, 0), a3, voffA);
            PG8_BAR; PG8_WAIT_L(0); PG8_MMA(1, 0, At, B0); PG8_BAR; PG8_SCHED;
            PG8_STAGE(PG8_SB(1, 1), b3 + hstepB, voffB);
            PG8_WAIT_V(6); PG8_BAR; PG8_MMA(1, 1, At, B1); PG8_BAR;
            }
        }
        if constexpr (ALIGN_EPI) { if (wr == 0) PG8_BAR; }
        if constexpr (!Epi::AFTER_DRAIN) { E(acc, cur, wr, wc, fr, fq); S.done(cur); }
        if (!has_next) break;
#pragma unroll
        for (int a = 0; a < 2; ++a)
#pragma unroll
            for (int b = 0; b < 2; ++b)
#pragma unroll
                for (int m = 0; m < 4; ++m)
#pragma unroll
                    for (int n = 0; n < 2; ++n) acc[a][b][m][n] = (f32x4){0.f, 0.f, 0.f, 0.f};
        cur = nxt; cA = nA; cB = nB; ++ui;
        if constexpr (ALIGN_EPI) { if (wr == 1) PG8_BAR; }
    }
    PG8_WAIT_V(0);
    if constexpr (!ALIGN_EPI) { if (wr == 0) PG8_BAR; }
    PG8_BAR;
    if constexpr (Epi::AFTER_DRAIN) { E.fused(acc, cur, wr, wc, fr, fq, lds, wid, lane); S.done(cur); }
#undef PG8_SA
#undef PG8_SB
#undef PG8_STAGE
#undef PG8_LDA
#undef PG8_LDB
#undef PG8_MMA
#undef PG8_WAIT_V
#undef PG8_WAIT_L
#undef PG8_BAR
#undef PG8_SCHED
}
}

#define GAS __attribute__((address_space(1)))
#define LAS __attribute__((address_space(3)))
typedef unsigned short bf16;
typedef unsigned v4u __attribute__((ext_vector_type(4)));
typedef float f32x4 __attribute__((ext_vector_type(4)));
typedef short bf16x8 __attribute__((ext_vector_type(8)));
typedef GAS unsigned gu32;
typedef GAS unsigned long long gu64;
#define RLX_AGENT __ATOMIC_RELAXED, __HIP_MEMORY_SCOPE_AGENT
#define LDS_WAIT() asm volatile("s_waitcnt lgkmcnt(0)" ::: "memory")
#define VM_WAIT() asm volatile("s_waitcnt vmcnt(0)" ::: "memory")
__device__ __forceinline__ unsigned long long rt() { return __builtin_amdgcn_s_memrealtime(); }
__device__ __forceinline__ unsigned f2bf(float f) { unsigned u = __builtin_bit_cast(unsigned, f); return (u + 0x7fffu + ((u >> 16) & 1u)) >> 16; }
__device__ __forceinline__ unsigned pk2(float lo, float hi) { return f2bf(lo) | (f2bf(hi) << 16); }

#define XB_TMO      128
#define XB_XCNT(j)  (256  + 64 * (j))
#define XB_XSUB(j)  (1280 + 64 * (j))
#define XB_XGEN(j)  (2304 + 64 * (j))
#define XB_TOP      3328
#define XB_TOPGEN   3392
#define XCD_BAR_WORDS 3456
#define XB_SPIN_CAP (1u << 18)

__device__ __forceinline__ unsigned xb_ld(unsigned* p)              { return __hip_atomic_load(p, __ATOMIC_RELAXED, __HIP_MEMORY_SCOPE_AGENT); }
__device__ __forceinline__ unsigned xb_add(unsigned* p, unsigned v) { return __hip_atomic_fetch_add(p, v, __ATOMIC_RELAXED, __HIP_MEMORY_SCOPE_AGENT); }
__device__ __forceinline__ unsigned xb_xcc_id() { return (unsigned)__builtin_amdgcn_s_getreg((3 << 11) | 20) & 0xFu; }
#define XB_SPIN(cond, bar) do { unsigned _sp = 0; while (cond) { __builtin_amdgcn_s_sleep(1); \
    if ((++_sp & 255u) == 0u) { if (xb_ld(&(bar)[XB_TMO])) break; if (_sp > XB_SPIN_CAP) { atomicAdd(&(bar)[XB_TMO], 1u); break; } } } } while (0)

struct XcdBarrier {
    unsigned* bar; unsigned x;
    volatile LAS unsigned* st;
};

__device__ __forceinline__ XcdBarrier xcd_barrier_post(unsigned* bar, volatile LAS unsigned* st) {
    XcdBarrier b; b.bar = bar; b.x = xb_xcc_id(); b.st = st;
    if (threadIdx.x == 0) (void)xb_add(&bar[XB_XCNT(b.x)], 1u);
    return b;
}
__device__ __forceinline__ void xcd_barrier_complete(unsigned* bar, unsigned x, unsigned& nloc, unsigned& nx) {
    const unsigned G = gridDim.x * gridDim.y * gridDim.z;
    unsigned sum, cnt, mine, sp = 0u;
    for (;;) {
        sum = 0u; cnt = 0u; mine = 0u;
#pragma unroll
        for (unsigned j = 0; j < 16; ++j) { const unsigned c = xb_ld(&bar[XB_XCNT(j)]); sum += c; cnt += (c > 0u) ? 1u : 0u; mine = (j == x) ? c : mine; }
        if (sum == G) break;
        __builtin_amdgcn_s_sleep(1);
        if ((++sp & 255u) == 0u) { if (xb_ld(&bar[XB_TMO])) break; if (sp > XB_SPIN_CAP) { atomicAdd(&bar[XB_TMO], 1u); break; } }
    }
    nloc = mine > 0u ? mine : 1u; nx = cnt > 0u ? cnt : 1u;
}

__device__ __forceinline__ void xcd_barrier(const XcdBarrier& b) {
    asm volatile("s_waitcnt vmcnt(0)" ::: "memory");
    __syncthreads();
    if (threadIdx.x == 0) {
        unsigned* bar = b.bar;
        __builtin_amdgcn_s_waitcnt(0);
        unsigned nloc = b.st[0], nx = b.st[1];
        if (nloc == 0u) { xcd_barrier_complete(bar, b.x, nloc, nx); b.st[0] = nloc; b.st[1] = nx; }
        const unsigned old = xb_add(&bar[XB_XSUB(b.x)], 1u);
        const unsigned gen = old / nloc;
        if (old + 1u == (gen + 1u) * nloc) {
            __builtin_amdgcn_fence(__ATOMIC_RELEASE, "agent");
            asm volatile("s_waitcnt vmcnt(0)" ::: "memory");
            const unsigned og = xb_add(&bar[XB_TOP], 1u);
            const unsigned tg = og / nx;
            if (og + 1u == (tg + 1u) * nx) xb_add(&bar[XB_TOPGEN], 1u);
            else XB_SPIN(xb_ld(&bar[XB_TOPGEN]) == tg, bar);
            __builtin_amdgcn_fence(__ATOMIC_ACQUIRE, "agent");
            xb_add(&bar[XB_XGEN(b.x)], 1u);
            asm volatile("s_waitcnt vmcnt(0)" ::: "memory");
        } else {
            XB_SPIN(xb_ld(&bar[XB_XGEN(b.x)]) == gen, bar);
            __builtin_amdgcn_fence(__ATOMIC_ACQUIRE, "agent");
            asm volatile("s_waitcnt vmcnt(0)" ::: "memory");
        }
    }
    __syncthreads();
}

constexpr int NWAVES = 8;
constexpr int BATCH = 32, SEQ = 2048, D = 1024, M = BATCH * SEQ;
constexpr int NH = 8, HD = 64, NKV = 2, IH = 8, IDIM = 64, NSEL = 256;
constexpr int DFF = 2816, NIN = 5448, NMOD = 6 * D;
constexpr int LDP = 5632;
constexpr int PC_Q = 0, PC_K = 512, PC_V = 640, PC_QI = 768, PC_KI = 1280, PC_WI = 1344, PC_XR = 1536, PC_YR = 2560, PC_GA = 3584, PC_GB = 4608;
constexpr int LDAR = 1536;
constexpr int HFF = DFF / 2;
constexpr float EPS = 1e-6f, LOG2E = 1.4426950408889634f, QSCALE = 0.125f * 1.4426950408889634f;

constexpr size_t MiB = 1u << 20;
constexpr size_t WS_CTL = 0, CTL_ZERO_BYTES = 1 * MiB;
constexpr size_t WS_MOD = 1 * MiB;
constexpr size_t WS_BIASP = 1 * MiB + 832 * 1024;
constexpr size_t WS_WIN = 2 * MiB, WS_WUP = 13 * MiB, WS_WDN = 24 * MiB, WS_WOA = 30 * MiB, WS_WOR = 31 * MiB, WS_WOUT = 33 * MiB, WS_WRG = 35 * MiB, WS_WIG = 35 * MiB + 512 * 1024;
constexpr size_t WS_VT = 40 * MiB;
constexpr size_t WS_A = 64 * MiB;
constexpr size_t WS_ACT = WS_A + 352 * MiB;
constexpr size_t WS_B = 768 * MiB;
constexpr size_t WS_C = 896 * MiB;
constexpr size_t WS_END = 1024 * MiB;
static_assert(WS_MOD + (size_t)BATCH * NMOD * 4 <= WS_BIASP && WS_BIASP + LDP * 4 <= WS_WIN, "ws map");
static_assert(WS_WIN + (size_t)LDP * D * 2 <= WS_WUP && WS_WUP + (size_t)LDP * D * 2 <= WS_WDN && WS_WDN + (size_t)D * DFF * 2 <= WS_WOA, "ws map");
static_assert(WS_A + (size_t)M * LDP * 2 <= WS_B && WS_ACT + (size_t)M * DFF * 2 <= WS_B && WS_B + (size_t)M * D * 2 <= WS_C && WS_C + (size_t)M * D * 2 <= WS_END, "ws map");
constexpr int CW_TMO = 0, CW_CODE = 1, CW_BAR = 4096;

constexpr int RING_OFF = 0, RING_BYTES = 131072;
constexpr int LDSCTL_OFF = RING_BYTES, MISC_OFF = LDSCTL_OFF + 320;
constexpr int LDS_BYTES = 147456;


typedef unsigned u32x2 __attribute__((ext_vector_type(2)));
typedef float f32x16 __attribute__((ext_vector_type(16)));
struct Frame {
    LAS unsigned char* lds;
    volatile LAS unsigned* MISC;
    gu32* ctl;
    int tid, lane, wave;
    int vcu, G;
    const float *x, *c, *w_ada, *b_ada, *g_mix, *w_in, *b_in, *rel_bias, *conv_rnn_w, *conv_rnn_b, *w_rg, *b_rg, *w_ig, *b_ig, *lru_lambda,
                *w_o_attn, *w_o_rnn, *w_out, *g_ffn, *w_up, *conv_ffn_w, *conv_ffn_b, *w_down, *g_final;
    float* out;
    float *mod, *biasp;
    bf16 *Win_t, *Wup_t, *Wdn_t, *Woa_t, *Wor_t, *Wout_t, *Wrg_t, *Wig_t;
    bf16 *VT, *P, *UPH, *ACT, *XN, *T1, *MG, *AR;
};
__device__ __forceinline__ float bf2f_lo(unsigned u) { return __uint_as_float(u << 16); }
__device__ __forceinline__ float bf2f_hi(unsigned u) { return __uint_as_float(u & 0xffff0000u); }
__device__ __forceinline__ float bf1(bf16 v) { return __uint_as_float(((unsigned)v) << 16); }
typedef float f32x2_t __attribute__((ext_vector_type(2))); typedef __bf16 bf16x2_t __attribute__((ext_vector_type(2)));
__device__ __forceinline__ unsigned cvtpk(float lo, float hi) { f32x2_t v = {lo, hi}; bf16x2_t b = __builtin_convertvector(v, bf16x2_t); return __builtin_bit_cast(unsigned, b); }
__device__ __forceinline__ float wave_sum(float v) {
#pragma unroll
    for (int o = 1; o < 64; o <<= 1) v += __shfl_xor(v, o);
    return v;
}
__device__ __forceinline__ float sigmoidf_(float x) { return __builtin_amdgcn_rcpf(1.f + __builtin_amdgcn_exp2f(-LOG2E * x)); }

__device__ __forceinline__ void tr_item(const float* W, int ldw, int k0, int c0, int nvalid, bf16* WT, int ldt, int r0, LAS float* scr, int lane) {
#pragma unroll 8
    for (int i = 0; i < 32; ++i) { const int kk = 2 * i + (lane >> 5), n = lane & 31; scr[kk * 33 + n] = (n < nvalid) ? W[(size_t)(k0 + kk) * ldw + c0 + n] : 0.f; }
    LDS_WAIT(); asm volatile("" ::: "memory");
    const int c = lane & 7;
#pragma unroll
    for (int j = 0; j < 4; ++j) { const int n = (lane >> 3) + 8 * j; const LAS float* s = scr + (8 * c) * 33 + n;
        v4u o; o.x = pk2(s[0 * 33], s[1 * 33]); o.y = pk2(s[2 * 33], s[3 * 33]); o.z = pk2(s[4 * 33], s[5 * 33]); o.w = pk2(s[6 * 33], s[7 * 33]);
        *(GAS v4u*)(WT + (size_t)(r0 + n) * ldt + k0 + 8 * c) = o; }
    LDS_WAIT(); asm volatile("" ::: "memory");
}
__device__ __forceinline__ int proj_src_col(int d) { return d < 1352 ? d : (d >= 1536 ? d - 184 : -1); }

__device__ __forceinline__ void p0_prologue(Frame& F) {
    LAS float* scr = (LAS float*)(F.lds + RING_OFF + F.wave * 16384);
    const int gw = F.vcu * NWAVES + F.wave, NGW = F.G * NWAVES;
    constexpr int I_IN = 16 * 176, I_UP = 16 * 176, I_DN = 44 * 32, I_OA = 8 * 32, I_OR = 16 * 32, I_OUT = 16 * 32, I_RG = 64, I_IG = 64;
    constexpr int NITEMS = I_IN + I_UP + I_DN + I_OA + I_OR + I_OUT + I_RG + I_IG;
    for (int it = gw; it < NITEMS; it += NGW) {
        int r = it;
        if (r < I_IN) { const int kb = r / 176, d0 = 32 * (r % 176); int c0 = 0, nv = 32;
            if (d0 < 1344) c0 = d0; else if (d0 == 1344) { c0 = 1344; nv = 8; } else if (d0 < 1536) { c0 = 0; nv = 0; } else c0 = d0 - 184;
            tr_item(F.w_in, NIN, 64 * kb, c0, nv, F.Win_t, D, d0, scr, F.lane); continue; } r -= I_IN;
        if (r < I_UP) { const int kb = r / 176, d0 = 32 * (r % 176); const int seg = d0 / HFF, off = d0 - seg * HFF;
            const int c0 = (seg == 0) ? off : (seg == 1) ? DFF + off : (seg == 2) ? HFF + off : DFF + HFF + off;
            tr_item(F.w_up, 2 * DFF, 64 * kb, c0, 32, F.Wup_t, D, d0, scr, F.lane); continue; } r -= I_UP;
        if (r < I_DN) { const int kb = r / 32, nb = r % 32; tr_item(F.w_down, D, 64 * kb, 32 * nb, 32, F.Wdn_t, DFF, 32 * nb, scr, F.lane); continue; } r -= I_DN;
        if (r < I_OA) { const int kb = r / 32, nb = r % 32; tr_item(F.w_o_attn, D, 64 * kb, 32 * nb, 32, F.Woa_t, 512, 32 * nb, scr, F.lane); continue; } r -= I_OA;
        if (r < I_OR) { const int kb = r / 32, nb = r % 32; tr_item(F.w_o_rnn, D, 64 * kb, 32 * nb, 32, F.Wor_t, D, 32 * nb, scr, F.lane); continue; } r -= I_OR;
        if (r < I_OUT) { const int kb = r / 32, nb = r % 32; tr_item(F.w_out, D, 64 * kb, 32 * nb, 32, F.Wout_t, D, 32 * nb, scr, F.lane); continue; } r -= I_OUT;
        if (r < I_RG) { const int blk = r / 8, rr = r % 8, kb = rr / 4, nb = rr % 4; tr_item(F.w_rg + blk * 16384, 128, 64 * kb, 32 * nb, 32, F.Wrg_t + blk * 16384, 128, 32 * nb, scr, F.lane); continue; } r -= I_RG;
        { const int blk = r / 8, rr = r % 8, kb = rr / 4, nb = rr % 4; tr_item(F.w_ig + blk * 16384, 128, 64 * kb, 32 * nb, 32, F.Wig_t + blk * 16384, 128, 32 * nb, scr, F.lane); }
    }
    for (int d = F.vcu * (NWAVES * 64) + F.tid; d < LDP; d += F.G * NWAVES * 64) { const int s = proj_src_col(d); F.biasp[d] = (s >= 0) ? F.b_in[s] : 0.f; }
    __syncthreads();
    for (int item = F.vcu; item < NMOD / 64; item += F.G) {
        LAS float* cs = (LAS float*)(F.lds + RING_OFF);
        for (int i = F.tid; i < BATCH * D; i += NWAVES * 64) { const float v = F.c[i]; cs[i] = v * sigmoidf_(v); }
        __syncthreads();
        const int col = item * 64 + F.lane, kbase = F.wave * 128;
        float acc[BATCH];
#pragma unroll
        for (int b = 0; b < BATCH; ++b) acc[b] = 0.f;
        for (int k4 = 0; k4 < 32; ++k4) {
            const int k = kbase + 4 * k4;
            const float w0 = F.w_ada[(size_t)(k + 0) * NMOD + col], w1 = F.w_ada[(size_t)(k + 1) * NMOD + col], w2 = F.w_ada[(size_t)(k + 2) * NMOD + col], w3 = F.w_ada[(size_t)(k + 3) * NMOD + col];
#pragma unroll
            for (int b = 0; b < BATCH; ++b) { const f32x4 c4 = *(const LAS f32x4*)(cs + b * D + k); acc[b] += (c4.x * w0 + c4.y * w1) + (c4.z * w2 + c4.w * w3); }
        }
        __syncthreads();
        LAS float* red = (LAS float*)(F.lds + RING_OFF);
#pragma unroll
        for (int b = 0; b < BATCH; ++b) red[(F.wave * BATCH + b) * 64 + F.lane] = acc[b];
        __syncthreads();
        for (int o = F.tid; o < BATCH * 64; o += NWAVES * 64) { const int b = o >> 6, l = o & 63; float s = F.b_ada[item * 64 + l];
#pragma unroll
            for (int w = 0; w < NWAVES; ++w) s += red[(w * BATCH + b) * 64 + l];
            F.mod[(size_t)b * NMOD + item * 64 + l] = s; }
        __syncthreads();
    }
}

__device__ __forceinline__ void p_norm_mod(Frame& F, const float* src, bf16* dst, const float* g, int sh_off, int sc_off) {
    const int gw = F.vcu * NWAVES + F.wave, NGW = F.G * NWAVES;
    for (int rb = gw; rb < M / 32; rb += NGW) {
        const int b = rb / (SEQ / 32);
        const float* mb = F.mod + (size_t)b * NMOD;
        f32x4 gm[4], sh[4];
#pragma unroll
        for (int j = 0; j < 4; ++j) { const int col = 4 * F.lane + 256 * j; const f32x4 gg = *(const f32x4*)(g + col), sc = *(const f32x4*)(mb + sc_off + col); sh[j] = *(const f32x4*)(mb + sh_off + col); gm[j] = gg * (sc + 1.0f); }
        for (int r = 0; r < 32; ++r) {
            const size_t row = (size_t)rb * 32 + r;
            const GAS f32x4* xr = (const GAS f32x4*)(src + row * D) + F.lane;
            f32x4 v[4]; float s = 0.f;
#pragma unroll
            for (int j = 0; j < 4; ++j) { v[j] = xr[64 * j]; s += (v[j].x * v[j].x + v[j].y * v[j].y) + (v[j].z * v[j].z + v[j].w * v[j].w); }
            const float rstd = 1.0f / sqrtf(wave_sum(s) * (1.f / D) + EPS);
            GAS u32x2* o8 = (GAS u32x2*)(dst + row * D) + F.lane;
#pragma unroll
            for (int j = 0; j < 4; ++j) { const f32x4 o = v[j] * rstd * gm[j] + sh[j]; u32x2 w; w.x = cvtpk(o.x, o.y); w.y = cvtpk(o.z, o.w); o8[64 * j] = w; }
        }
    }
}
__device__ __forceinline__ void p_norm_final(Frame& F) {
    const int gw = F.vcu * NWAVES + F.wave, NGW = F.G * NWAVES;
    f32x4 gm[4];
#pragma unroll
    for (int j = 0; j < 4; ++j) gm[j] = *(const f32x4*)(F.g_final + 4 * F.lane + 256 * j);
    for (int rb = gw; rb < M / 32; rb += NGW)
        for (int r = 0; r < 32; ++r) {
            const size_t row = (size_t)rb * 32 + r;
            GAS f32x4* xr = (GAS f32x4*)(F.out + row * D) + F.lane;
            f32x4 v[4]; float s = 0.f;
#pragma unroll
            for (int j = 0; j < 4; ++j) { v[j] = xr[64 * j]; s += (v[j].x * v[j].x + v[j].y * v[j].y) + (v[j].z * v[j].z + v[j].w * v[j].w); }
            const float rstd = 1.0f / sqrtf(wave_sum(s) * (1.f / D) + EPS);
#pragma unroll
            for (int j = 0; j < 4; ++j) xr[64 * j] = v[j] * rstd * gm[j];
        }
}

__device__ __forceinline__ void p_act(Frame& F, int half) {
    constexpr int NCG = HFF / 8;
    const int T = F.vcu * (NWAVES * 64) + F.tid, NT = F.G * NWAVES * 64, nslots = NT / NCG;
    if (T >= nslots * NCG) return;
    const int cg = T % NCG, slot = T / NCG;
    const int j0 = cg * 8, jg = half * HFF + j0;
    float wv[3][8], wg[3][8], bv[8], bg[8];
#pragma unroll
    for (int k = 0; k < 3; ++k)
#pragma unroll
        for (int e = 0; e < 8; ++e) { wv[k][e] = F.conv_ffn_w[(size_t)k * (2 * DFF) + jg + e]; wg[k][e] = F.conv_ffn_w[(size_t)k * (2 * DFF) + DFF + jg + e]; }
#pragma unroll
    for (int e = 0; e < 8; ++e) { bv[e] = F.conv_ffn_b[jg + e]; bg[e] = F.conv_ffn_b[DFF + jg + e]; }
    for (int rc = slot; rc < M / 16; rc += nslots) {
        const size_t t0 = (size_t)rc * 16;
        const bool first = (t0 % SEQ) == 0;
        const bf16* up = F.UPH + t0 * DFF + j0;
        v4u v2 = {0, 0, 0, 0}, v1 = {0, 0, 0, 0}, g2 = {0, 0, 0, 0}, g1 = {0, 0, 0, 0};
        if (!first) { v2 = *(const v4u*)(up - 2 * (ptrdiff_t)DFF); v1 = *(const v4u*)(up - (ptrdiff_t)DFF); g2 = *(const v4u*)(up - 2 * (ptrdiff_t)DFF + HFF); g1 = *(const v4u*)(up - (ptrdiff_t)DFF + HFF); }
        bf16* ap = F.ACT + t0 * DFF + jg;
#pragma unroll 4
        for (int r = 0; r < 16; ++r) {
            const v4u v0 = *(const v4u*)(up + (size_t)r * DFF), g0 = *(const v4u*)(up + (size_t)r * DFF + HFF);
            float o[8];
#pragma unroll
            for (int q = 0; q < 4; ++q) {
                const unsigned a2 = v2[q], a1 = v1[q], a0 = v0[q], c2 = g2[q], c1 = g1[q], c0 = g0[q];
                const float vl = wv[0][2 * q] * bf2f_lo(a2) + wv[1][2 * q] * bf2f_lo(a1) + wv[2][2 * q] * bf2f_lo(a0) + bv[2 * q];
                const float vh = wv[0][2 * q + 1] * bf2f_hi(a2) + wv[1][2 * q + 1] * bf2f_hi(a1) + wv[2][2 * q + 1] * bf2f_hi(a0) + bv[2 * q + 1];
                const float gl = wg[0][2 * q] * bf2f_lo(c2) + wg[1][2 * q] * bf2f_lo(c1) + wg[2][2 * q] * bf2f_lo(c0) + bg[2 * q];
                const float gh = wg[0][2 * q + 1] * bf2f_hi(c2) + wg[1][2 * q + 1] * bf2f_hi(c1) + wg[2][2 * q + 1] * bf2f_hi(c0) + bg[2 * q + 1];
                o[2 * q] = gl * sigmoidf_(gl) * vl; o[2 * q + 1] = gh * sigmoidf_(gh) * vh;
            }
            v4u w; w.x = cvtpk(o[0], o[1]); w.y = cvtpk(o[2], o[3]); w.z = cvtpk(o[4], o[5]); w.w = cvtpk(o[6], o[7]);
            *(v4u*)(ap + (size_t)r * DFF) = w;
            v2 = v1; v1 = v0; g2 = g1; g1 = g0;
        }
    }
}

__constant__ unsigned char T5_BUCKET[128] = {
    0, 1, 2, 3, 4, 5, 6, 7, 8, 9, 10, 11, 12, 13, 14, 15, 16, 16, 16, 17, 17, 18, 18, 18, 19, 19, 19, 20, 20, 20, 20, 21, 21, 21, 21, 22, 22, 22, 22, 22,
    23, 23, 23, 23, 23, 23, 24, 24, 24, 24, 24, 24, 25, 25, 25, 25, 25, 25, 25, 26, 26, 26, 26, 26, 26, 26, 26, 27, 27, 27, 27, 27, 27, 27, 27, 27, 27,
    28, 28, 28, 28, 28, 28, 28, 28, 28, 28, 29, 29, 29, 29, 29, 29, 29, 29, 29, 29, 29, 29, 30, 30, 30, 30, 30, 30, 30, 30, 30, 30, 30, 30, 30, 30,
    31, 31, 31, 31, 31, 31, 31, 31, 31, 31, 31, 31, 31, 31, 31};
constexpr int ATT_MASK_OFF = 0, ATT_TBL_OFF = 16384;
__device__ __forceinline__ unsigned ord_key(float s) { const unsigned u = __float_as_uint(s); return (u & 0x80000000u) ? ~u : (u | 0x80000000u); }

__device__ __forceinline__ void attn_unit(Frame& F, int b, int qb) {
    const int lane = F.lane, w = F.wave, l32 = lane & 31, g = lane >> 5;
    LAS unsigned* maskL = (LAS unsigned*)(F.lds + RING_OFF + ATT_MASK_OFF);
    const LAS float* tbl = (const LAS float*)(F.lds + RING_OFF + ATT_TBL_OFF);
    const size_t tok0 = (size_t)b * SEQ;
    const int qw = qb * 64 + 8 * w;
    const int nkt = 2 * (qb + 1);
    const bf16* Pb = F.P + tok0 * LDP;

#ifndef NO_PASS1
    for (int tile = 0; tile < 2; ++tile) {
        const int qq = 2 * ((l32 >> 2) & 1) + (l32 >> 4), hd = ((l32 >> 3) & 1) * 4 + (l32 & 3);
        const bf16* qrow = Pb + (size_t)(qw + 4 * tile + qq) * LDP + PC_QI + hd * 64 + 8 * g;
        bf16x8 af[4];
#pragma unroll
        for (int ks = 0; ks < 4; ++ks) af[ks] = *(const bf16x8*)(qrow + 16 * ks);
        const int t0q = qw + 4 * tile + 2 * g;
        float wq[2][8];
#pragma unroll
        for (int e = 0; e < 2; ++e) { const v4u wv = *(const v4u*)(Pb + (size_t)(t0q + e) * LDP + PC_WI);
            wq[e][0] = bf2f_lo(wv.x); wq[e][1] = bf2f_hi(wv.x); wq[e][2] = bf2f_lo(wv.y); wq[e][3] = bf2f_hi(wv.y); wq[e][4] = bf2f_lo(wv.z); wq[e][5] = bf2f_hi(wv.z); wq[e][6] = bf2f_lo(wv.w); wq[e][7] = bf2f_hi(wv.w); }
        unsigned keys[64][2];
        int l32v = l32; asm volatile("" : "+v"(l32v));
        const GAS char* pbase = (const GAS char*)Pb; asm volatile("" : "+s"(pbase));
        int nktv = nkt; asm volatile("" : "+s"(nktv));
        const unsigned kvoff = (unsigned)((l32v * LDP + PC_KI + 8 * g) * 2);
        bf16x8 bq[2][4];
#pragma unroll
        for (int ks = 0; ks < 4; ++ks) { bq[0][ks] = *(const GAS bf16x8*)(pbase + kvoff + 32 * ks); bq[1][ks] = bq[0][ks]; }
#pragma unroll
        for (int kt = 0; kt < 64; ++kt) {
            if (kt < nktv) {
                if (kt + 1 < nktv) {
#pragma unroll
                    for (int ks = 0; ks < 4; ++ks) bq[(kt + 1) & 1][ks] = *(const GAS bf16x8*)(pbase + (size_t)(kt + 1) * (32 * LDP * 2) + kvoff + 32 * ks);
                }
                __builtin_amdgcn_sched_barrier(0);
                f32x16 acc = {0.f, 0.f, 0.f, 0.f, 0.f, 0.f, 0.f, 0.f, 0.f, 0.f, 0.f, 0.f, 0.f, 0.f, 0.f, 0.f};
#pragma unroll
                for (int ks = 0; ks < 4; ++ks) acc = __builtin_amdgcn_mfma_f32_32x32x16_bf16(af[ks], bq[kt & 1][ks], acc, 0, 0, 0);
                float s0 = 0.f, s1 = 0.f;
#pragma unroll
                for (int r = 0; r < 8; ++r) { s0 += wq[0][r] * __builtin_amdgcn_fmed3f(acc[r], 0.f, __builtin_inff()); s1 += wq[1][r] * __builtin_amdgcn_fmed3f(acc[8 + r], 0.f, __builtin_inff()); }
                const int sidx = 32 * kt + l32v; const unsigned low = 2047u - (unsigned)sidx;
                keys[kt][0] = (sidx <= t0q) ? ((ord_key(s0) & 0xFFFFF800u) | low) : 0u;
                keys[kt][1] = (sidx <= t0q + 1) ? ((ord_key(s1) & 0xFFFFF800u) | low) : 0u;
            } else { keys[kt][0] = 0u; keys[kt][1] = 0u; }
            __builtin_amdgcn_sched_barrier(0);
        }
        unsigned T0 = 0u, T1 = 0u; bool d0 = false, d1 = false;
#ifdef EXP_SELECT_ALL
        T0 = 1u; d0 = true; T1 = 1u; d1 = true;
#else
        if (t0q + 1 <= NSEL) { T0 = 1u; d0 = true; }
        if (t0q + 2 <= NSEL) { T1 = 1u; d1 = true; }
#endif
        for (int bit = 31; bit >= 0; --bit) {
            if (__all(d0 && d1)) break;
            const unsigned c0 = T0 | (1u << bit), c1 = T1 | (1u << bit);
            unsigned cnt = 0u;
#pragma unroll
            for (int gq = 0; gq < 4; ++gq)
                if (16 * gq < nktv) {
#pragma unroll
                    for (int k2 = 0; k2 < 16; ++k2) { cnt += (keys[16 * gq + k2][0] >= c0) ? 1u : 0u; cnt += (keys[16 * gq + k2][1] >= c1) ? 0x10000u : 0u; }
                }
#pragma unroll
            for (int o = 1; o < 32; o <<= 1) cnt += __shfl_xor(cnt, o);
            const unsigned n0 = cnt & 0xffffu, n1 = cnt >> 16;
            if (!d0) { if (n0 >= (unsigned)NSEL) T0 = c0; if (n0 == (unsigned)NSEL) d0 = true; }
            if (!d1) { if (n1 >= (unsigned)NSEL) T1 = c1; if (n1 == (unsigned)NSEL) d1 = true; }
        }
        const int qloc = 8 * w + 4 * tile + 2 * g;
#pragma unroll
        for (int kt = 0; kt < 64; ++kt)
            if (kt < nktv) {
                const unsigned long long b0 = __ballot(keys[kt][0] >= T0), b1 = __ballot(keys[kt][1] >= T1);
                if (l32 == 0) { maskL[(qloc + 0) * 64 + kt] = g ? (unsigned)(b0 >> 32) : (unsigned)b0; maskL[(qloc + 1) * 64 + kt] = g ? (unsigned)(b1 >> 32) : (unsigned)b1; }
            }
    }

#endif
#ifndef NO_PASS2
    {
        const int ql8 = l32 >> 2, hl = l32 & 3;
        const int tq = qw + ql8;
        const bf16* qrow = Pb + (size_t)tq * LDP + PC_Q + 8 * g;
        bf16x8 qf[2][4];
#pragma unroll
        for (int gk = 0; gk < 2; ++gk)
#pragma unroll
            for (int ks = 0; ks < 4; ++ks) qf[gk][ks] = *(const bf16x8*)(qrow + (4 * gk + hl) * 64 + 16 * ks);
        f32x16 O[2][2];
#pragma unroll
        for (int gk = 0; gk < 2; ++gk)
#pragma unroll
            for (int mt = 0; mt < 2; ++mt)
#pragma unroll
                for (int r = 0; r < 16; ++r) O[gk][mt][r] = 0.f;
        float lsum[2] = {0.f, 0.f}, mrun[2] = {0.f, 0.f};
        const float b31[2] = {tbl[hl * 128 + 127], tbl[(4 + hl) * 128 + 127]};
        const bf16* VTb = F.VT + (size_t)b * (2 * 64) * SEQ;
        const LAS unsigned* mrow = maskL + (8 * w + ql8) * 64;
        bool first = true;
        for (int kt = 0; kt < nkt; ++kt) {
            const unsigned mword = mrow[kt];
            if (__ballot(mword != 0u) == 0ull) continue;
            const unsigned mg = mword >> (4 * g);
            const bool far = (qw - (32 * kt + 31)) >= 113;
            const bf16* krow = Pb + (size_t)(32 * kt + l32) * LDP + PC_K + 8 * g;
#pragma unroll
            for (int gk = 0; gk < 2; ++gk) {
                f32x16 S = {0.f, 0.f, 0.f, 0.f, 0.f, 0.f, 0.f, 0.f, 0.f, 0.f, 0.f, 0.f, 0.f, 0.f, 0.f, 0.f};
#pragma unroll
                for (int ks = 0; ks < 4; ++ks) S = __builtin_amdgcn_mfma_f32_32x32x16_bf16(*(const bf16x8*)(krow + gk * 64 + 16 * ks), qf[gk][ks], S, 0, 0, 0);
                float x[16];
                if (far) { const float cb = b31[gk] - mrun[gk];
#pragma unroll
                    for (int r = 0; r < 16; ++r) x[r] = S[r] + cb;
                } else { const LAS float* tb = tbl + (4 * gk + hl) * 128; const int dbase = tq - 32 * kt - 4 * g; const float mr = mrun[gk];
#pragma unroll
                    for (int r = 0; r < 16; ++r) { int dd = dbase - ((r & 3) + 8 * (r >> 2)); dd = dd < 0 ? 0 : (dd > 127 ? 127 : dd); x[r] = S[r] + (tb[dd] - mr); }
                }
                float tm = x[0];
#pragma unroll
                for (int r = 1; r < 16; ++r) tm = fmaxf(tm, x[r]);
                tm = fmaxf(tm, __shfl_xor(tm, 32));
                if (first) { mrun[gk] = tm;
#pragma unroll
                    for (int r = 0; r < 16; ++r) x[r] -= tm;
                } else if (__any(tm > 8.f)) {
                    const float dl = fmaxf(tm, 0.f), alpha = __builtin_amdgcn_exp2f(-dl);
                    mrun[gk] += dl; lsum[gk] *= alpha;
#pragma unroll
                    for (int r = 0; r < 16; ++r) x[r] -= dl;
#pragma unroll
                    for (int mt = 0; mt < 2; ++mt)
#pragma unroll
                        for (int r = 0; r < 16; ++r) O[gk][mt][r] *= alpha;
                }
                float ps = 0.f; unsigned pk[8];
#pragma unroll
                for (int r = 0; r < 16; r += 2) {
                    const int bp0 = 8 * (r >> 2) + (r & 3), bp1 = 8 * ((r + 1) >> 2) + ((r + 1) & 3);
                    const unsigned sm0 = (unsigned)(((int)(mg << (31 - bp0))) >> 31), sm1 = (unsigned)(((int)(mg << (31 - bp1))) >> 31);
                    const float p0 = __uint_as_float(__float_as_uint(__builtin_amdgcn_exp2f(x[r])) & sm0), p1 = __uint_as_float(__float_as_uint(__builtin_amdgcn_exp2f(x[r + 1])) & sm1);
                    ps += p0 + p1; pk[r >> 1] = cvtpk(p0, p1);
                }
                lsum[gk] += ps;
                bf16x8 pf[2];
                { v4u t0 = {pk[0], pk[1], pk[2], pk[3]}, t1 = {pk[4], pk[5], pk[6], pk[7]}; pf[0] = __builtin_bit_cast(bf16x8, t0); pf[1] = __builtin_bit_cast(bf16x8, t1); }
#pragma unroll
                for (int mt = 0; mt < 2; ++mt)
#pragma unroll
                    for (int s = 0; s < 2; ++s) {
                        const bf16* vp = VTb + (size_t)(gk * 64 + 32 * mt + l32) * SEQ + 32 * kt + 16 * s + 4 * g;
                        const u32x2 lo = *(const u32x2*)vp, hi = *(const u32x2*)(vp + 8);
                        v4u vv = {lo.x, lo.y, hi.x, hi.y};
                        O[gk][mt] = __builtin_amdgcn_mfma_f32_32x32x16_bf16(__builtin_bit_cast(bf16x8, vv), pf[s], O[gk][mt], 0, 0, 0);
                    }
            }
            first = false;
        }
        bf16* orow = F.AR + (tok0 + tq) * LDAR;
#pragma unroll
        for (int gk = 0; gk < 2; ++gk) {
            const float lt = lsum[gk] + __shfl_xor(lsum[gk], 32), inv = 1.0f / lt;
#pragma unroll
            for (int mt = 0; mt < 2; ++mt)
#pragma unroll
                for (int i = 0; i < 4; ++i) { const int d = 32 * mt + 8 * i + 4 * g;
                    u32x2 wv; wv.x = cvtpk(O[gk][mt][4 * i] * inv, O[gk][mt][4 * i + 1] * inv); wv.y = cvtpk(O[gk][mt][4 * i + 2] * inv, O[gk][mt][4 * i + 3] * inv);
                    *(u32x2*)(orow + (4 * gk + hl) * 64 + d) = wv; }
        }
    }
#endif
}

constexpr int LRU_XCF = 0, LRU_ABF = 32768, LRU_ABF_STRIDE = 272, LRU_RAW = 51200, LRU_GY = 69632, LRU_OUT = 86016;
__device__ __forceinline__ void lru_unit(Frame& F, int b, int n) {
    const int tid = F.tid, lane = F.lane, w = F.wave, l16 = lane & 15, q = lane >> 4;
    LAS unsigned char* L = F.lds + RING_OFF;
    LAS float* XCF = (LAS float*)(L + LRU_XCF);
    LAS unsigned char* ABF = L + LRU_ABF;
    LAS bf16* RAW = (LAS bf16*)(L + LRU_RAW);
    LAS bf16* GY = (LAS bf16*)(L + LRU_GY);
    LAS bf16* OUTS = (LAS bf16*)(L + LRU_OUT);
    const size_t tok0 = (size_t)b * SEQ;
    const bf16* Pb = F.P + tok0 * LDP;
    const int ch0 = n * 128;
    bf16x8 brg[4], big[4];
    { const bf16* wr = F.Wrg_t + (size_t)n * 16384 + (16 * w + l16) * 128 + 8 * q; const bf16* wi = F.Wig_t + (size_t)n * 16384 + (16 * w + l16) * 128 + 8 * q;
#pragma unroll
      for (int ks = 0; ks < 4; ++ks) { brg[ks] = *(const bf16x8*)(wr + 32 * ks); big[ks] = *(const bf16x8*)(wi + 32 * ks); } }
    const int dch = ch0 + 16 * w + l16;
    const float brg_b = F.b_rg[dch], big_b = F.b_ig[dch];
    const float lam = F.lru_lambda[dch];
    const float sp = fmaxf(-lam, 0.f) + log1pf(expf(-fabsf(lam)));
    const float a_coef = -8.0f * sp;
    const int cc = tid & 127, tseg = tid >> 7;
    const float cw0 = F.conv_rnn_w[0 * D + ch0 + cc], cw1 = F.conv_rnn_w[1 * D + ch0 + cc], cw2 = F.conv_rnn_w[2 * D + ch0 + cc], cw3 = F.conv_rnn_w[3 * D + ch0 + cc], cbias = F.conv_rnn_b[ch0 + cc];
    float hprev = 0.f;
    v4u raw[3], gyr[2];
#define LRU_LOAD(t0_) do { _Pragma("unroll") for (int i_ = 0; i_ < 3; ++i_) { const int idx_ = tid + 512 * i_; raw[i_] = (v4u){0u, 0u, 0u, 0u}; \
            if (idx_ < 67 * 16) { const int row_ = idx_ >> 4, part_ = idx_ & 15, t_ = (t0_) - 3 + row_; if (t_ >= 0) raw[i_] = *(const v4u*)(Pb + (size_t)t_ * LDP + PC_XR + ch0 + 8 * part_); } } \
        _Pragma("unroll") for (int i_ = 0; i_ < 2; ++i_) { const int idx_ = tid + 512 * i_, row_ = idx_ >> 4, part_ = idx_ & 15; gyr[i_] = *(const v4u*)(Pb + (size_t)((t0_) + row_) * LDP + PC_YR + ch0 + 8 * part_); } } while (0)
    LRU_LOAD(0);
    for (int chunk = 0; chunk < SEQ / 64; ++chunk) {
        const int t0 = chunk * 64;
#pragma unroll
        for (int i = 0; i < 3; ++i) { const int idx = tid + 512 * i; if (idx < 67 * 16) *(LAS v4u*)(RAW + idx * 8) = raw[i]; }
#pragma unroll
        for (int i = 0; i < 2; ++i) { const int idx = tid + 512 * i; *(LAS v4u*)(GY + idx * 8) = gyr[i]; }
        __syncthreads();
        if (chunk + 1 < SEQ / 64) LRU_LOAD(t0 + 64);
        { float x0 = bf1(RAW[(16 * tseg + 0) * 128 + cc]), x1 = bf1(RAW[(16 * tseg + 1) * 128 + cc]), x2 = bf1(RAW[(16 * tseg + 2) * 128 + cc]);
#pragma unroll
          for (int tt = 0; tt < 16; ++tt) { const int t = 16 * tseg + tt; const float x3 = bf1(RAW[(t + 3) * 128 + cc]);
              const float xc = cbias + cw0 * x0 + cw1 * x1 + cw2 * x2 + cw3 * x3;
              XCF[t * 128 + cc] = xc; *(LAS bf16*)(ABF + t * LRU_ABF_STRIDE + cc * 2) = (bf16)f2bf(xc);
              x0 = x1; x1 = x2; x2 = x3; } }
        __syncthreads();
#pragma unroll 1
        for (int rt = 0; rt < 4; ++rt) {
            f32x4 accR = {0.f, 0.f, 0.f, 0.f}, accI = {0.f, 0.f, 0.f, 0.f};
            const LAS unsigned char* ap = ABF + (16 * rt + l16) * LRU_ABF_STRIDE + 16 * q;
#pragma unroll
            for (int ks = 0; ks < 4; ++ks) { const bf16x8 af = *(const LAS bf16x8*)(ap + 64 * ks);
                accR = __builtin_amdgcn_mfma_f32_16x16x32_bf16(af, brg[ks], accR, 0, 0, 0); accI = __builtin_amdgcn_mfma_f32_16x16x32_bf16(af, big[ks], accI, 0, 0, 0); }
            float Ap[4], Hl[4];
#pragma unroll
            for (int r = 0; r < 4; ++r) { const int tt = 16 * rt + 4 * q + r; const float xc = XCF[tt * 128 + 16 * w + l16];
                const float rr = sigmoidf_(accR[r] + brg_b), ii = sigmoidf_(accI[r] + big_b);
                const float la = a_coef * rr, a = expf(la), mult = sqrtf(-expm1f(2.0f * la)), u = xc * ii * mult;
                if (r == 0) { Ap[0] = a; Hl[0] = u; } else { Ap[r] = Ap[r - 1] * a; Hl[r] = a * Hl[r - 1] + u; } }
            float A = Ap[3], H = Hl[3];
            { const float Au = __shfl_up(A, 16), Hu = __shfl_up(H, 16); if (q >= 1) { H = A * Hu + H; A = A * Au; } }
            { const float Au = __shfl_up(A, 32), Hu = __shfl_up(H, 32); if (q >= 2) { H = A * Hu + H; A = A * Au; } }
            float Ae = __shfl_up(A, 16), He = __shfl_up(H, 16); if (q == 0) { Ae = 1.f; He = 0.f; }
            const float hin = He + Ae * hprev;
            const float A3 = __shfl(A, 48 + l16), H3 = __shfl(H, 48 + l16);
            hprev = H3 + A3 * hprev;
#pragma unroll
            for (int r = 0; r < 4; ++r) { const int tt = 16 * rt + 4 * q + r; const float h = Hl[r] + Ap[r] * hin; const float gv = bf1(GY[tt * 128 + 16 * w + l16]);
                OUTS[tt * 128 + 16 * w + l16] = (bf16)f2bf(h * gv); }
        }
        __syncthreads();
#pragma unroll
        for (int i = 0; i < 2; ++i) { const int idx = tid + 512 * i, row = idx >> 4, part = idx & 15;
            *(v4u*)(F.AR + (tok0 + t0 + row) * LDAR + 512 + ch0 + 8 * part) = *(const LAS v4u*)(OUTS + idx * 8); }
    }
#undef LRU_LOAD
}

__device__ __forceinline__ void p3_mixers(Frame& F) {
    { LAS float* tbl = (LAS float*)(F.lds + RING_OFF + ATT_TBL_OFF);
      for (int i = F.tid; i < 8 * 128; i += NWAVES * 64) { const int h = i >> 7, d = i & 127; tbl[i] = F.rel_bias[(int)T5_BUCKET[d] * NH + h] * LOG2E; } }
    __syncthreads();
    for (int e = F.vcu; e < 1024; e += F.G) {
        const int k = e >> 8, r = e & 255, b = r >> 3, j = r & 7;
        const int qb = (k == 0) ? 31 - j : (k == 1) ? 16 + j : (k == 2) ? 15 - j : j;
#ifndef NO_ATT
        attn_unit(F, b, qb);
#else
        for (int i = F.tid; i < 64 * 64; i += NWAVES * 64) { const int row = i >> 6, part = i & 63; *(v4u*)(F.AR + ((size_t)b * SEQ + qb * 64 + row) * LDAR + 8 * part) = (v4u){0u, 0u, 0u, 0u}; }
#endif
    }
    __syncthreads();
#ifndef NO_LRU
    for (int u = F.vcu; u < BATCH * 8; u += F.G) lru_unit(F, u >> 3, u & 7);
#else
    for (int u = F.vcu; u < BATCH * 8; u += F.G) { const int b = u >> 3, n = u & 7;
        for (int i = F.tid; i < SEQ * 16; i += NWAVES * 64) { const int row = i >> 4, part = i & 15; *(v4u*)(F.AR + ((size_t)b * SEQ + row) * LDAR + 512 + n * 128 + 8 * part) = (v4u){0u, 0u, 0u, 0u}; } }
#endif
}

#ifndef MK_N_LAUNCHES
#define MK_N_LAUNCHES 1
#endif
constexpr int N_PHASES = 14;

#define CAS __attribute__((address_space(4)))
__device__ __forceinline__ void frame_ptrs(Frame& F) {
    const CAS unsigned long long* kp = (const CAS unsigned long long*)__builtin_amdgcn_kernarg_segment_ptr();
    asm volatile("" : "+s"(kp));
    { int t_ = threadIdx.x; asm volatile("" : "+v"(t_)); F.tid = t_; F.lane = t_ & 63; }
#define KIN(k) ((const float*)(const GAS float*)kp[k])
    F.x = KIN(0); F.c = KIN(1); F.w_ada = KIN(2); F.b_ada = KIN(3); F.g_mix = KIN(4); F.w_in = KIN(5); F.b_in = KIN(6); F.rel_bias = KIN(7);
    F.conv_rnn_w = KIN(8); F.conv_rnn_b = KIN(9); F.w_rg = KIN(10); F.b_rg = KIN(11); F.w_ig = KIN(12); F.b_ig = KIN(13); F.lru_lambda = KIN(14);
    F.w_o_attn = KIN(15); F.w_o_rnn = KIN(16); F.w_out = KIN(17); F.g_ffn = KIN(18); F.w_up = KIN(19); F.conv_ffn_w = KIN(20); F.conv_ffn_b = KIN(21);
    F.w_down = KIN(22); F.g_final = KIN(23);
#undef KIN
    F.out = (float*)(GAS float*)kp[24];
    GAS unsigned char* ws = (GAS unsigned char*)kp[25];
    F.mod = (float*)(ws + WS_MOD); F.biasp = (float*)(ws + WS_BIASP);
    F.Win_t = (bf16*)(ws + WS_WIN); F.Wup_t = (bf16*)(ws + WS_WUP); F.Wdn_t = (bf16*)(ws + WS_WDN); F.Woa_t = (bf16*)(ws + WS_WOA); F.Wor_t = (bf16*)(ws + WS_WOR); F.Wout_t = (bf16*)(ws + WS_WOUT);
    F.Wrg_t = (bf16*)(ws + WS_WRG); F.Wig_t = (bf16*)(ws + WS_WIG);
    F.VT = (bf16*)(ws + WS_VT); F.P = (bf16*)(ws + WS_A); F.UPH = (bf16*)(ws + WS_A); F.ACT = (bf16*)(ws + WS_ACT); F.XN = (bf16*)(ws + WS_B); F.T1 = (bf16*)(ws + WS_B); F.MG = (bf16*)(ws + WS_C);
    F.AR = (bf16*)(GAS bf16*)kp[24];
}
struct Args { const float* in[24]; float* out; unsigned char* ws; int ph_lo, ph_hi; };
__global__ void __launch_bounds__(NWAVES * 64, 2) mk_fwd(Args args) {
    extern __shared__ __attribute__((aligned(16))) unsigned char lds[];
    Frame F;
    F.lds = (LAS unsigned char*)lds;
    F.MISC = (volatile LAS unsigned*)(F.lds + MISC_OFF);
    F.tid = threadIdx.x; F.lane = F.tid & 63; F.wave = __builtin_amdgcn_readfirstlane(F.tid >> 6);
    F.G = gridDim.x; { const int bx = blockIdx.x; F.vcu = (F.G % 8 == 0) ? (bx % 8) * (F.G / 8) + bx / 8 : bx; }
    F.ctl = (gu32*)(args.ws + WS_CTL);
    for (int u = F.tid; u < (LDS_BYTES - LDSCTL_OFF) / 4; u += NWAVES * 64) ((LAS unsigned*)(F.lds + LDSCTL_OFF))[u] = 0u;
    __syncthreads();
    const int lo = args.ph_lo, hi = args.ph_hi;
    XcdBarrier bar; bar.bar = (unsigned*)(F.ctl + CW_BAR); bar.x = 0; bar.st = nullptr;
    if (hi - lo > 1) bar = xcd_barrier_post((unsigned*)(F.ctl + CW_BAR), F.MISC + 8);
#ifndef PHASE_MASK
#define PHASE_MASK 0xFFFFu
#endif
#define IN(k) (((PHASE_MASK >> (k)) & 1u) && lo <= (k) && (k) < hi)
#define SEAM(k) do { if (IN(k) && IN((k) + 1)) xcd_barrier(bar); } while (0)
    typedef pg8::bf16_t gb;

    if (IN(0)) { frame_ptrs(F); p0_prologue(F); } SEAM(0);
    if (IN(1)) { frame_ptrs(F); p_norm_mod(F, F.x, F.XN, F.g_mix, 0 * D, 1 * D); } SEAM(1);
    if (IN(2)) { frame_ptrs(F);
        pg8::Gemm g{(const gb*)F.XN, (const gb*)F.Win_t, M, LDP, D, D, D}; pg8::StaticOrder S; S.init(M, LDP, F.G, (int)blockIdx.x);
        pg8::EpiProj E{(gb*)F.P, LDP, F.biasp, (gb*)F.VT, SEQ, QSCALE};
        pg8::gemm_phase<pg8::EpiProj, pg8::StaticOrder, true, true>(F.lds + RING_OFF, g, S, E);
    } SEAM(2);
    if (IN(3)) { frame_ptrs(F); p3_mixers(F); } SEAM(3);
    if (IN(4)) { frame_ptrs(F);
        pg8::Gemm g{(const gb*)F.AR, (const gb*)F.Woa_t, M, D, 512, LDAR, 512}; pg8::StaticOrder S; S.init(M, D, F.G, (int)blockIdx.x);
        pg8::EpiGate<false> E{(const gb*)F.P + PC_GA, LDP, nullptr, (gb*)F.T1, D};
        pg8::gemm_phase<pg8::EpiGate<false>, pg8::StaticOrder, true, true>(F.lds + RING_OFF, g, S, E);
    } SEAM(4);
    if (IN(5)) { frame_ptrs(F);
        pg8::Gemm g{(const gb*)F.AR + 512, (const gb*)F.Wor_t, M, D, D, LDAR, D}; pg8::StaticOrder S; S.init(M, D, F.G, (int)blockIdx.x);
        pg8::EpiGate<true> E{(const gb*)F.P + PC_GB, LDP, (const gb*)F.T1, (gb*)F.MG, D};
        pg8::gemm_phase<pg8::EpiGate<true>, pg8::StaticOrder, true, true>(F.lds + RING_OFF, g, S, E);
    } SEAM(5);
    if (IN(6)) { frame_ptrs(F);
        pg8::Gemm g{(const gb*)F.MG, (const gb*)F.Wout_t, M, D, D, D, D}; pg8::StaticOrder S; S.init(M, D, F.G, (int)blockIdx.x);
        pg8::EpiResid E{F.x, F.out, D, F.mod + 2 * D, NMOD, SEQ};
        pg8::gemm_phase<pg8::EpiResid, pg8::StaticOrder, true, true>(F.lds + RING_OFF, g, S, E);
    } SEAM(6);
    if (IN(7)) { frame_ptrs(F); p_norm_mod(F, F.out, F.XN, F.g_ffn, 3 * D, 4 * D); } SEAM(7);
    if (IN(8)) { frame_ptrs(F);
        pg8::Gemm g{(const gb*)F.XN, (const gb*)F.Wup_t, M, DFF, D, D, D}; pg8::StaticOrder S; S.init(M, DFF, F.G, (int)blockIdx.x);
        pg8::EpiBf16Plain E{(gb*)F.UPH, DFF};
        pg8::gemm_phase<pg8::EpiBf16Plain, pg8::StaticOrder, true, true>(F.lds + RING_OFF, g, S, E);
    } SEAM(8);
    if (IN(9)) { frame_ptrs(F); p_act(F, 0); } SEAM(9);
    if (IN(10)) { frame_ptrs(F);
        pg8::Gemm g{(const gb*)F.XN, (const gb*)F.Wup_t + (size_t)DFF * D, M, DFF, D, D, D}; pg8::StaticOrder S; S.init(M, DFF, F.G, (int)blockIdx.x);
        pg8::EpiBf16Plain E{(gb*)F.UPH, DFF};
        pg8::gemm_phase<pg8::EpiBf16Plain, pg8::StaticOrder, true, true>(F.lds + RING_OFF, g, S, E);
    } SEAM(10);
    if (IN(11)) { frame_ptrs(F); p_act(F, 1); } SEAM(11);
    if (IN(12)) { frame_ptrs(F);
        pg8::Gemm g{(const gb*)F.ACT, (const gb*)F.Wdn_t, M, D, DFF, DFF, DFF}; pg8::StaticOrder S; S.init(M, D, F.G, (int)blockIdx.x);
        pg8::EpiResid E{F.out, F.out, D, F.mod + 5 * D, NMOD, SEQ};
        pg8::gemm_phase<pg8::EpiResid, pg8::StaticOrder, true, true>(F.lds + RING_OFF, g, S, E);
    } SEAM(12);
    if (IN(13)) { frame_ptrs(F); p_norm_final(F); }
#undef IN
#undef SEAM
}

extern "C" void kernel_launch(void* const* d_in, const int* in_sizes, int n_in, void* d_out, int out_size, void* d_ws, size_t ws_size, hipStream_t stream) {
    static int grid = 0;
    if (grid == 0) {
        if (n_in != 24 || in_sizes[0] != M * D || out_size != M * D || ws_size < WS_END) { fprintf(stderr, "kernel_launch: unexpected shapes (n_in %d, in0 %d, out %d, ws %zu); nothing launched\n", n_in, n_in > 0 ? in_sizes[0] : -1, out_size, ws_size); grid = -1; return; }
        int dev = 0, cus = 0, per_cu = 0;
        if (hipGetDevice(&dev) != hipSuccess || hipDeviceGetAttribute(&cus, hipDeviceAttributeMultiprocessorCount, dev) != hipSuccess) { grid = -1; return; }
        if (hipFuncSetAttribute((const void*)mk_fwd, hipFuncAttributeMaxDynamicSharedMemorySize, LDS_BYTES) != hipSuccess) { fprintf(stderr, "kernel_launch: hipFuncSetAttribute failed\n"); grid = -1; return; }
        if (hipOccupancyMaxActiveBlocksPerMultiprocessor(&per_cu, (const void*)mk_fwd, NWAVES * 64, LDS_BYTES) != hipSuccess || per_cu < 1) { fprintf(stderr, "kernel_launch: occupancy query reports %d blocks per CU\n", per_cu); }
        (void)hipGetLastError();
        grid = cus;
    }
    if (grid < 0) return;
    if (hipMemsetAsync((char*)d_ws + WS_CTL, 0, CTL_ZERO_BYTES, stream) != hipSuccess) { fprintf(stderr, "kernel_launch: memset failed\n"); return; }
    Args a{};
    for (int i = 0; i < 24; ++i) a.in[i] = (const float*)d_in[i];
    a.out = (float*)d_out; a.ws = (unsigned char*)d_ws;
#if MK_N_LAUNCHES == 1
    a.ph_lo = 0; a.ph_hi = N_PHASES;
    hipLaunchKernelGGL(mk_fwd, dim3(grid), dim3(NWAVES * 64), LDS_BYTES, stream, a);
#else
    for (int p = 0; p < N_PHASES; ++p) { a.ph_lo = p; a.ph_hi = p + 1; hipLaunchKernelGGL(mk_fwd, dim3(grid), dim3(NWAVES * 64), LDS_BYTES, stream, a); }
#endif
    const hipError_t le = hipPeekAtLastError();
    if (le != hipSuccess) fprintf(stderr, "kernel_launch: launch failed: %s\n", hipGetErrorName(le));
}
```

```cpp
#define MK_N_LAUNCHES 1
#include <hip/hip_runtime.h>
#include <cstdio>
#include <cstdint>
namespace pg8 {
#define PG8_LAS __attribute__((address_space(3)))
typedef unsigned short bf16_t;
typedef short bf16x8 __attribute__((ext_vector_type(8)));
typedef float f32x4 __attribute__((ext_vector_type(4)));
typedef unsigned u32x4 __attribute__((ext_vector_type(4)));
constexpr int BM = 256, BK = 64, HALF = 128, HTB = HALF * BK * 2  , STAGE_BYTES = 8 * HTB, NXCD = 8, WGM = 8;

__host__ __device__ __forceinline__ int lds_byte(int r, int c) { const int st = (r >> 4) * 2 + (c >> 5), rr = r & 15, cc = c & 31, ob = rr * 64 + cc * 2; return st * 1024 + (ob ^ (((ob >> 9) & 1) << 5)); }
__host__ __device__ __forceinline__ void stage_rc(int b, int& R, int& C) { const int st = b / 1024, sb = b % 1024, swz = sb ^ (((sb >> 9) & 1) << 5); R = (st >> 1) * 16 + swz / 64; C = (st & 1) * 32 + (swz % 64) / 2; }
__host__ __device__ __forceinline__ int perm32(int rho) { const int n = rho >> 4, i = rho & 15; return 8 * (i >> 2) + 4 * n + (i & 3); }

struct Unit { int pm, pn; };
struct Gemm { const bf16_t* A; const bf16_t* Bt; int M, N, K, lda, ldb; };

struct StaticOrder {
    int nM, nN, nwg, G, c;
    __host__ __device__ void init(int M, int N, int G_, int c_) { nM = M / BM; nN = N / BM; nwg = nM * nN; G = G_; c = c_; }
    __host__ __device__ bool next(int i, Unit& u) const {
        const long L = (long)i * G + c; if (L >= nwg) return false;
        int wgid = (int)L; { const int q = nwg / NXCD, r = nwg % NXCD, xcd = wgid % NXCD, off = wgid / NXCD; wgid = (xcd < r ? xcd * (q + 1) : r * (q + 1) + (xcd - r) * q) + off; }
        const int nig = WGM * nN, gid = wgid / nig, fm = gid * WGM, gsz = (nM - fm) < WGM ? (nM - fm) : WGM;
        u.pm = fm + ((wgid % nig) % gsz); u.pn = (wgid % nig) / gsz; return true;
    }
    __device__ __forceinline__ void a_ready(const Unit&) const {}
    __device__ __forceinline__ void done(const Unit&) const {}
};

typedef float f32x2 __attribute__((ext_vector_type(2))); typedef __bf16 bf16x2v __attribute__((ext_vector_type(2)));
__device__ __forceinline__ unsigned cvt_pk_bf16(float lo, float hi) { f32x2 v = {lo, hi}; bf16x2v b = __builtin_convertvector(v, bf16x2v); return __builtin_bit_cast(unsigned, b); }
typedef unsigned u32x2 __attribute__((ext_vector_type(2)));
__device__ __forceinline__ float bf_lo(unsigned u) { return __uint_as_float(u << 16); }
__device__ __forceinline__ float bf_hi(unsigned u) { return __uint_as_float(u & 0xffff0000u); }
__device__ __forceinline__ float fast_sigmoid(float x) { return __builtin_amdgcn_rcpf(1.f + __builtin_amdgcn_exp2f(-1.4426950408889634f * x)); }
__device__ __forceinline__ float gelu_tanh(float x) { const float z = 1.5957691216057308f * x * (1.f + 0.044715f * x * x); return x * fast_sigmoid(z); }

struct EpiBf16Plain {
    static constexpr bool PERM = true, AFTER_DRAIN = false;
    bf16_t* O; int ldc;
    __device__ __forceinline__ void operator()(const f32x4 (&acc)[2][2][4][2], const Unit& u, int wr, int wc, int fr, int fq) const {
        const int row0 = u.pm * BM + wr * 64 + fr, col0 = u.pn * BM + wc * 32 + 8 * fq;
#pragma unroll
        for (int ai = 0; ai < 2; ++ai)
#pragma unroll
            for (int m = 0; m < 4; ++m) { bf16_t* rowp = O + (size_t)(row0 + ai * HALF + m * 16) * ldc + col0;
#pragma unroll
                for (int bj = 0; bj < 2; ++bj) { const f32x4 v0 = acc[ai][bj][m][0], v1 = acc[ai][bj][m][1];
                    u32x4 w; w.x = cvt_pk_bf16(v0[0], v0[1]); w.y = cvt_pk_bf16(v0[2], v0[3]); w.z = cvt_pk_bf16(v1[0], v1[1]); w.w = cvt_pk_bf16(v1[2], v1[3]);
                    *(u32x4*)(rowp + bj * HALF) = w; } }
    }
};

struct EpiProj {
    static constexpr bool PERM = true, AFTER_DRAIN = false;
    bf16_t* P; int ldp; const float* bias; bf16_t* VT; int seq; float c2;
    template <int KIND> __device__ __forceinline__ void run(const f32x4 (&acc)[2][2][4][2], const Unit& u, int wr, int wc, int fr, int fq) const {
        const int row0 = u.pm * BM + wr * 64 + fr, col0 = u.pn * BM + wc * 32 + 8 * fq;
        f32x4 bv[2][2];
#pragma unroll
        for (int bj = 0; bj < 2; ++bj)
#pragma unroll
            for (int n = 0; n < 2; ++n) bv[bj][n] = *(const f32x4*)(bias + col0 + bj * HALF + 4 * n);
#pragma unroll
        for (int ai = 0; ai < 2; ++ai)
#pragma unroll
            for (int m = 0; m < 4; ++m) { const int row = row0 + ai * HALF + m * 16; bf16_t* rowp = P + (size_t)row * ldp + col0;
#pragma unroll
                for (int bj = 0; bj < 2; ++bj) { f32x4 v0 = acc[ai][bj][m][0] + bv[bj][0], v1 = acc[ai][bj][m][1] + bv[bj][1];
                    if (KIND == 0) { v0 = v0 * c2; v1 = v1 * c2; }
                    if (KIND == 3) { v0 = (f32x4){gelu_tanh(v0[0]), gelu_tanh(v0[1]), gelu_tanh(v0[2]), gelu_tanh(v0[3])}; v1 = (f32x4){gelu_tanh(v1[0]), gelu_tanh(v1[1]), gelu_tanh(v1[2]), gelu_tanh(v1[3])}; }
                    if (KIND == 4) { v0 = (f32x4){fast_sigmoid(v0[0]), fast_sigmoid(v0[1]), fast_sigmoid(v0[2]), fast_sigmoid(v0[3])}; v1 = (f32x4){fast_sigmoid(v1[0]), fast_sigmoid(v1[1]), fast_sigmoid(v1[2]), fast_sigmoid(v1[3])}; }
                    u32x4 w; w.x = cvt_pk_bf16(v0[0], v0[1]); w.y = cvt_pk_bf16(v0[2], v0[3]); w.z = cvt_pk_bf16(v1[0], v1[1]); w.w = cvt_pk_bf16(v1[2], v1[3]);
                    *(u32x4*)(rowp + bj * HALF) = w;
                    if (KIND == 1 && bj == 1) {
                        const int b = row / seq, s = row - b * seq, dv0 = wc * 32 + 8 * fq;
                        bf16_t* vt = VT + ((size_t)(b * 2 + (dv0 >> 6)) * 64 + (dv0 & 63)) * seq + s;
                        vt[0 * (size_t)seq] = (bf16_t)(w.x & 0xffffu); vt[1 * (size_t)seq] = (bf16_t)(w.x >> 16);
                        vt[2 * (size_t)seq] = (bf16_t)(w.y & 0xffffu); vt[3 * (size_t)seq] = (bf16_t)(w.y >> 16);
                        vt[4 * (size_t)seq] = (bf16_t)(w.z & 0xffffu); vt[5 * (size_t)seq] = (bf16_t)(w.z >> 16);
                        vt[6 * (size_t)seq] = (bf16_t)(w.w & 0xffffu); vt[7 * (size_t)seq] = (bf16_t)(w.w >> 16);
                    } } }
    }
    __device__ __forceinline__ void operator()(const f32x4 (&acc)[2][2][4][2], const Unit& u, int wr, int wc, int fr, int fq) const {
        const int pn = u.pn;
        if (pn < 2) run<0>(acc, u, wr, wc, fr, fq);
        else if (pn == 2) run<1>(acc, u, wr, wc, fr, fq);
        else if (pn < 10) run<2>(acc, u, wr, wc, fr, fq);
        else if (pn < 14) run<3>(acc, u, wr, wc, fr, fq);
        else run<4>(acc, u, wr, wc, fr, fq);
    }
};

template <bool ADD> struct EpiGate {
    static constexpr bool PERM = true, AFTER_DRAIN = false;
    const bf16_t* G; int ldg; const bf16_t* base; bf16_t* O; int ldc;
    __device__ __forceinline__ void operator()(const f32x4 (&acc)[2][2][4][2], const Unit& u, int wr, int wc, int fr, int fq) const {
        const int row0 = u.pm * BM + wr * 64 + fr, col0 = u.pn * BM + wc * 32 + 8 * fq;
#pragma unroll
        for (int ai = 0; ai < 2; ++ai)
#pragma unroll
            for (int m = 0; m < 4; ++m) { const size_t row = (size_t)(row0 + ai * HALF + m * 16);
#pragma unroll
                for (int bj = 0; bj < 2; ++bj) { const int col = col0 + bj * HALF;
                    const u32x4 gq = *(const u32x4*)(G + row * ldg + col);
                    f32x4 v0 = acc[ai][bj][m][0], v1 = acc[ai][bj][m][1];
                    v0 = v0 * (f32x4){bf_lo(gq.x), bf_hi(gq.x), bf_lo(gq.y), bf_hi(gq.y)}; v1 = v1 * (f32x4){bf_lo(gq.z), bf_hi(gq.z), bf_lo(gq.w), bf_hi(gq.w)};
                    if (ADD) { const u32x4 bq = *(const u32x4*)(base + row * ldc + col);
                        v0 = v0 + (f32x4){bf_lo(bq.x), bf_hi(bq.x), bf_lo(bq.y), bf_hi(bq.y)}; v1 = v1 + (f32x4){bf_lo(bq.z), bf_hi(bq.z), bf_lo(bq.w), bf_hi(bq.w)}; }
                    u32x4 w; w.x = cvt_pk_bf16(v0[0], v0[1]); w.y = cvt_pk_bf16(v0[2], v0[3]); w.z = cvt_pk_bf16(v1[0], v1[1]); w.w = cvt_pk_bf16(v1[2], v1[3]);
                    *(u32x4*)(O + row * ldc + col) = w; } }
    }
};

struct EpiResid {
    static constexpr bool PERM = false, AFTER_DRAIN = false;
    const float* base; float* out; int ldc; const float* gvec; int gstride; int seq;
    __device__ __forceinline__ void operator()(const f32x4 (&acc)[2][2][4][2], const Unit& u, int wr, int wc, int fr, int fq) const {
        const int row0 = u.pm * BM + wr * 64 + fr, col0 = u.pn * BM + wc * 32 + 4 * fq;
        const float* gv = gvec + (size_t)((u.pm * BM) / seq) * gstride;
        f32x4 g4[2][2];
#pragma unroll
        for (int bj = 0; bj < 2; ++bj)
#pragma unroll
            for (int n = 0; n < 2; ++n) g4[bj][n] = *(const f32x4*)(gv + col0 + bj * HALF + n * 16);
#pragma unroll
        for (int ai = 0; ai < 2; ++ai)
#pragma unroll
            for (int m = 0; m < 4; ++m) { const size_t off = (size_t)(row0 + ai * HALF + m * 16) * ldc + col0;
#pragma unroll
                for (int bj = 0; bj < 2; ++bj)
#pragma unroll
                    for (int n = 0; n < 2; ++n) { const f32x4 bs = *(const f32x4*)(base + off + bj * HALF + n * 16);
                        *(f32x4*)(out + off + bj * HALF + n * 16) = bs + g4[bj][n] * acc[ai][bj][m][n]; }
                if (m & 1) asm volatile("" ::: "memory"); }
    }
};

template <class Epi, class Sched, bool ALIGN_EPI = false, bool SP2 = false>
__device__ __forceinline__ void gemm_phase(PG8_LAS unsigned char* lds, const Gemm g, const Sched& S, const Epi& E) {
    const int tid = threadIdx.x, wid = __builtin_amdgcn_readfirstlane(tid >> 6), lane = tid & 63, wr = wid >> 2, wc = wid & 3, fr = lane & 15, fq = lane >> 4;
    const int K = g.K, nt = K / BK;
    unsigned voffA[2], voffB[2];
#pragma unroll
    for (int i = 0; i < 2; ++i) { int R, C; stage_rc(tid * 16 + i * 8192, R, C); const int Rb = Epi::PERM ? ((R & ~31) + perm32(R & 31)) : R;
        voffA[i] = (unsigned)(R * g.lda + C) * 2u; voffB[i] = (unsigned)(Rb * g.ldb + C) * 2u; }
    const size_t kstep = (size_t)(BK * 2);
    const size_t hstepA = (size_t)HALF * g.lda * 2, hstepB = (size_t)HALF * g.ldb * 2;
    const size_t tstepA = 2 * hstepA, tstepB = 2 * hstepB;
    const unsigned ldsw = (unsigned)wid * 1024u;
    const int aoff = lds_byte(wr * 64 + fr, fq * 8), boff = lds_byte(wc * 32 + fr, fq * 8);
#define PG8_SA(b, h) (((b) * 2 + (h)) * HTB)
#define PG8_SB(b, h) ((4 + (b) * 2 + (h)) * HTB)
#define PG8_STAGE(bufoff, gbase, voff) do { _Pragma("unroll") for (int _i = 0; _i < 2; ++_i) \
        __builtin_amdgcn_global_load_lds((const unsigned*)((const char*)(gbase) + (voff)[_i]), (PG8_LAS unsigned*)(lds + (bufoff) + ldsw + _i * 8192), 16, 0, 0); } while (0)
#define PG8_LDA(dst, b, h) do { _Pragma("unroll") for (int m = 0; m < 4; ++m) _Pragma("unroll") for (int k = 0; k < 2; ++k) dst[m][k] = *(const PG8_LAS bf16x8*)(lds + PG8_SA(b, h) + aoff + m * 2048 + k * 1024); } while (0)
#define PG8_LDB(dst, b, h) do { _Pragma("unroll") for (int n = 0; n < 2; ++n) _Pragma("unroll") for (int k = 0; k < 2; ++k) dst[n][k] = *(const PG8_LAS bf16x8*)(lds + PG8_SB(b, h) + boff + n * 2048 + k * 1024); } while (0)
#define PG8_MMA(ai, bj, At, Bt) do { __builtin_amdgcn_s_setprio(1); _Pragma("unroll") for (int m = 0; m < 4; ++m) _Pragma("unroll") for (int n = 0; n < 2; ++n) _Pragma("unroll") for (int k = 0; k < 2; ++k) \
        acc[ai][bj][m][n] = __builtin_amdgcn_mfma_f32_16x16x32_bf16(Bt[n][k], At[m][k], acc[ai][bj][m][n], 0, 0, 0); __builtin_amdgcn_s_setprio(0); } while (0)
#define PG8_WAIT_V(n) asm volatile("s_waitcnt vmcnt(" #n ")" ::: "memory")
#define PG8_WAIT_L(n) asm volatile("s_waitcnt lgkmcnt(" #n ")" ::: "memory")
#define PG8_BAR __builtin_amdgcn_s_barrier()
#define PG8_SCHED __builtin_amdgcn_sched_barrier(0)
    Unit cur, nxt; int ui = 0;
    if (!S.next(0, cur)) return;
    f32x4 acc[2][2][4][2];
#pragma unroll
    for (int a = 0; a < 2; ++a)
#pragma unroll
        for (int b = 0; b < 2; ++b)
#pragma unroll
            for (int m = 0; m < 4; ++m)
#pragma unroll
                for (int n = 0; n < 2; ++n) acc[a][b][m][n] = (f32x4){0.f, 0.f, 0.f, 0.f};
    bf16x8 At[4][2], B0[2][2], B1[2][2];
    const char* cA = (const char*)g.A + (size_t)cur.pm * tstepA; const char* cB = (const char*)g.Bt + (size_t)cur.pn * tstepB;
    S.a_ready(cur);
    if constexpr (SP2) {
        PG8_STAGE(PG8_SB(0, 0), cB, voffB); PG8_STAGE(PG8_SB(0, 1), cB + hstepB, voffB); PG8_STAGE(PG8_SA(0, 0), cA, voffA); PG8_STAGE(PG8_SA(0, 1), cA + hstepA, voffA);
        if (wr == 1) PG8_BAR;
        PG8_WAIT_V(2); PG8_BAR;
        PG8_STAGE(PG8_SB(1, 0), cB + kstep, voffB); PG8_STAGE(PG8_SA(1, 0), cA + kstep, voffA); PG8_STAGE(PG8_SB(1, 1), cB + hstepB + kstep, voffB);
        PG8_WAIT_V(6); PG8_BAR;
    } else {
        PG8_STAGE(PG8_SB(0, 0), cB, voffB); PG8_STAGE(PG8_SA(0, 0), cA, voffA); PG8_STAGE(PG8_SB(0, 1), cB + hstepB, voffB); PG8_STAGE(PG8_SA(0, 1), cA + hstepA, voffA);
        if (wr == 1) PG8_BAR;
        PG8_WAIT_V(4); PG8_BAR;
        PG8_STAGE(PG8_SB(1, 0), cB + kstep, voffB); PG8_STAGE(PG8_SA(1, 0), cA + kstep, voffA); PG8_STAGE(PG8_SB(1, 1), cB + hstepB + kstep, voffB);
        PG8_WAIT_V(6); PG8_BAR;
    }
    for (;;) {
        const bool has_next = S.next(ui + 1, nxt);
        const char* nA = has_next ? (const char*)g.A + (size_t)nxt.pm * tstepA : cA; const char* nB = has_next ? (const char*)g.Bt + (size_t)nxt.pn * tstepB : cB;
        for (int t = 0; t < nt; t += 2) {
            const bool last = (t == nt - 2);
            const char* a1 = cA + (size_t)(t + 1) * kstep;
            const char* a2 = last ? nA : cA + (size_t)(t + 2) * kstep; const char* b2 = last ? nB : cB + (size_t)(t + 2) * kstep;
            const char* a3 = a2 + kstep; const char* b3 = b2 + kstep;
            if (last && has_next) S.a_ready(nxt);
            if constexpr (SP2) {
            PG8_LDB(B0, 0, 0); PG8_LDB(B1, 0, 1); PG8_SCHED; PG8_LDA(At, 0, 0); PG8_STAGE(PG8_SA(1, 1), a1 + hstepA, voffA);
            PG8_WAIT_V(8); PG8_WAIT_L(0); PG8_BAR; PG8_MMA(0, 0, At, B0); PG8_MMA(0, 1, At, B1); PG8_BAR; PG8_SCHED;
            PG8_LDA(At, 0, 1); PG8_STAGE(PG8_SB(0, 0), b2, voffB); PG8_STAGE(PG8_SB(0, 1), b2 + hstepB, voffB); PG8_STAGE(PG8_SA(0, 0), a2, voffA);
            PG8_WAIT_V(8); PG8_WAIT_L(0); PG8_BAR; PG8_MMA(1, 0, At, B0); PG8_MMA(1, 1, At, B1); PG8_BAR; PG8_SCHED;
            PG8_LDB(B0, 1, 0); PG8_LDB(B1, 1, 1); PG8_SCHED; PG8_LDA(At, 1, 0); PG8_STAGE(PG8_SA(0, 1), a2 + hstepA, voffA);
            PG8_WAIT_V(8); PG8_WAIT_L(0); PG8_BAR; PG8_MMA(0, 0, At, B0); PG8_MMA(0, 1, At, B1); PG8_BAR; PG8_SCHED;
            PG8_LDA(At, 1, 1); PG8_STAGE(PG8_SB(1, 0), b3, voffB); PG8_STAGE(PG8_SB(1, 1), b3 + hstepB, voffB); PG8_STAGE(PG8_SA(1, 0), a3, voffA);
            PG8_WAIT_V(8); PG8_WAIT_L(0); PG8_BAR; PG8_MMA(1, 0, At, B0); PG8_MMA(1, 1, At, B1); PG8_BAR; PG8_SCHED;
            } else {
            PG8_LDB(B0, 0, 0); PG8_SCHED; PG8_LDA(At, 0, 0); PG8_STAGE(PG8_SA(1, 1), a1 + hstepA, voffA);
            PG8_WAIT_L(8); PG8_BAR; PG8_WAIT_L(0); PG8_MMA(0, 0, At, B0); PG8_BAR; PG8_SCHED;
            PG8_LDB(B1, 0, 1); PG8_STAGE(PG8_SB(0, 0), b2, voffB);
            PG8_BAR; PG8_WAIT_L(0); PG8_MMA(0, 1, At, B1); PG8_BAR;
            PG8_LDA(At, 0, 1); PG8_STAGE(PG8_SA(0, 0), a2, voffA);
            PG8_BAR; PG8_WAIT_L(0); PG8_MMA(1, 0, At, B0); PG8_BAR; PG8_SCHED;
            PG8_STAGE(PG8_SB(0, 1), b2 + hstepB, voffB);
            PG8_WAIT_V(6); PG8_BAR; PG8_MMA(1, 1, At, B1); PG8_BAR;
            PG8_LDB(B0, 1, 0); PG8_SCHED; PG8_LDA(At, 1, 0); PG8_STAGE(PG8_SA(0, 1), a2 + hstepA, voffA);
            PG8_WAIT_L(8); PG8_BAR; PG8_WAIT_L(0); PG8_MMA(0, 0, At, B0); PG8_BAR; PG8_SCHED;
            PG8_LDB(B1, 1, 1); PG8_STAGE(PG8_SB(1, 0), b3, voffB);
            PG8_BAR; PG8_WAIT_L(0); PG8_MMA(0, 1, At, B1); PG8_BAR;
            PG8_LDA(At, 1, 1); PG8_STAGE(PG8_SA(1, 0), a3, voffA);
            PG8_BAR; PG8_WAIT_L(0); PG8_MMA(1, 0, At, B0); PG8_BAR; PG8_SCHED;
            PG8_STAGE(PG8_SB(1, 1), b3 + hstepB, voffB);
            PG8_WAIT_V(6); PG8_BAR; PG8_MMA(1, 1, At, B1); PG8_BAR;
            }
        }
        if constexpr (ALIGN_EPI) { if (wr == 0) PG8_BAR; }
        if constexpr (!Epi::AFTER_DRAIN) { E(acc, cur, wr, wc, fr, fq); S.done(cur); }
        if (!has_next) break;
#pragma unroll
        for (int a = 0; a < 2; ++a)
#pragma unroll
            for (int b = 0; b < 2; ++b)
#pragma unroll
                for (int m = 0; m < 4; ++m)
#pragma unroll
                    for (int n = 0; n < 2; ++n) acc[a][b][m][n] = (f32x4){0.f, 0.f, 0.f, 0.f};
        cur = nxt; cA = nA; cB = nB; ++ui;
        if constexpr (ALIGN_EPI) { if (wr == 1) PG8_BAR; }
    }
    PG8_WAIT_V(0);
    if constexpr (!ALIGN_EPI) { if (wr == 0) PG8_BAR; }
    PG8_BAR;
    if constexpr (Epi::AFTER_DRAIN) { E.fused(acc, cur, wr, wc, fr, fq, lds, wid, lane); S.done(cur); }
#undef PG8_SA
#undef PG8_SB
#undef PG8_STAGE
#undef PG8_LDA
#undef PG8_LDB
#undef PG8_MMA
#undef PG8_WAIT_V
#undef PG8_WAIT_L
#undef PG8_BAR
#undef PG8_SCHED
}
}

#define GAS __attribute__((address_space(1)))
#define LAS __attribute__((address_space(3)))
typedef unsigned short bf16;
typedef unsigned v4u __attribute__((ext_vector_type(4)));
typedef float f32x4 __attribute__((ext_vector_type(4)));
typedef short bf16x8 __attribute__((ext_vector_type(8)));
typedef GAS unsigned gu32;
typedef GAS unsigned long long gu64;
#define RLX_AGENT __ATOMIC_RELAXED, __HIP_MEMORY_SCOPE_AGENT
#define LDS_WAIT() asm volatile("s_waitcnt lgkmcnt(0)" ::: "memory")
#define VM_WAIT() asm volatile("s_waitcnt vmcnt(0)" ::: "memory")
__device__ __forceinline__ unsigned long long rt() { return __builtin_amdgcn_s_memrealtime(); }
__device__ __forceinline__ unsigned f2bf(float f) { unsigned u = __builtin_bit_cast(unsigned, f); return (u + 0x7fffu + ((u >> 16) & 1u)) >> 16; }
__device__ __forceinline__ unsigned pk2(float lo, float hi) { return f2bf(lo) | (f2bf(hi) << 16); }

#define XB_TMO      128
#define XB_XCNT(j)  (256  + 64 * (j))
#define XB_XSUB(j)  (1280 + 64 * (j))
#define XB_XGEN(j)  (2304 + 64 * (j))
#define XB_TOP      3328
#define XB_TOPGEN   3392
#define XCD_BAR_WORDS 3456
#define XB_SPIN_CAP (1u << 18)

__device__ __forceinline__ unsigned xb_ld(unsigned* p)              { return __hip_atomic_load(p, __ATOMIC_RELAXED, __HIP_MEMORY_SCOPE_AGENT); }
__device__ __forceinline__ unsigned xb_add(unsigned* p, unsigned v) { return __hip_atomic_fetch_add(p, v, __ATOMIC_RELAXED, __HIP_MEMORY_SCOPE_AGENT); }
__device__ __forceinline__ unsigned xb_xcc_id() { return (unsigned)__builtin_amdgcn_s_getreg((3 << 11) | 20) & 0xFu; }
#define XB_SPIN(cond, bar) do { unsigned _sp = 0; while (cond) { __builtin_amdgcn_s_sleep(1); \
    if ((++_sp & 255u) == 0u) { if (xb_ld(&(bar)[XB_TMO])) break; if (_sp > XB_SPIN_CAP) { atomicAdd(&(bar)[XB_TMO], 1u); break; } } } } while (0)

struct XcdBarrier {
    unsigned* bar; unsigned x;
    volatile LAS unsigned* st;
};

__device__ __forceinline__ XcdBarrier xcd_barrier_post(unsigned* bar, volatile LAS unsigned* st) {
    XcdBarrier b; b.bar = bar; b.x = xb_xcc_id(); b.st = st;
    if (threadIdx.x == 0) (void)xb_add(&bar[XB_XCNT(b.x)], 1u);
    return b;
}
__device__ __forceinline__ void xcd_barrier_complete(unsigned* bar, unsigned x, unsigned& nloc, unsigned& nx) {
    const unsigned G = gridDim.x * gridDim.y * gridDim.z;
    unsigned sum, cnt, mine, sp = 0u;
    for (;;) {
        sum = 0u; cnt = 0u; mine = 0u;
#pragma unroll
        for (unsigned j = 0; j < 16; ++j) { const unsigned c = xb_ld(&bar[XB_XCNT(j)]); sum += c; cnt += (c > 0u) ? 1u : 0u; mine = (j == x) ? c : mine; }
        if (sum == G) break;
        __builtin_amdgcn_s_sleep(1);
        if ((++sp & 255u) == 0u) { if (xb_ld(&bar[XB_TMO])) break; if (sp > XB_SPIN_CAP) { atomicAdd(&bar[XB_TMO], 1u); break; } }
    }
    nloc = mine > 0u ? mine : 1u; nx = cnt > 0u ? cnt : 1u;
}

__device__ __forceinline__ void xcd_barrier(const XcdBarrier& b) {
    asm volatile("s_waitcnt vmcnt(0)" ::: "memory");
    __syncthreads();
    if (threadIdx.x == 0) {
        unsigned* bar = b.bar;
        __builtin_amdgcn_s_waitcnt(0);
        unsigned nloc = b.st[0], nx = b.st[1];
        if (nloc == 0u) { xcd_barrier_complete(bar, b.x, nloc, nx); b.st[0] = nloc; b.st[1] = nx; }
        const unsigned old = xb_add(&bar[XB_XSUB(b.x)], 1u);
        const unsigned gen = old / nloc;
        if (old + 1u == (gen + 1u) * nloc) {
            __builtin_amdgcn_fence(__ATOMIC_RELEASE, "agent");
            asm volatile("s_waitcnt vmcnt(0)" ::: "memory");
            const unsigned og = xb_add(&bar[XB_TOP], 1u);
            const unsigned tg = og / nx;
            if (og + 1u == (tg + 1u) * nx) xb_add(&bar[XB_TOPGEN], 1u);
            else XB_SPIN(xb_ld(&bar[XB_TOPGEN]) == tg, bar);
            __builtin_amdgcn_fence(__ATOMIC_ACQUIRE, "agent");
            xb_add(&bar[XB_XGEN(b.x)], 1u);
            asm volatile("s_waitcnt vmcnt(0)" ::: "memory");
        } else {
            XB_SPIN(xb_ld(&bar[XB_XGEN(b.x)]) == gen, bar);
            __builtin_amdgcn_fence(__ATOMIC_ACQUIRE, "agent");
            asm volatile("s_waitcnt vmcnt(0)" ::: "memory");
        }
    }
    __syncthreads();
}

constexpr int NWAVES = 8;
constexpr int BATCH = 32, SEQ = 2048, D = 1024, M = BATCH * SEQ;
constexpr int NH = 8, HD = 64, NKV = 2, IH = 8, IDIM = 64, NSEL = 256;
constexpr int DFF = 2816, NIN = 5448, NMOD = 6 * D;
constexpr int LDP = 5632;
constexpr int PC_Q = 0, PC_K = 512, PC_V = 640, PC_QI = 768, PC_KI = 1280, PC_WI = 1344, PC_XR = 1536, PC_YR = 2560, PC_GA = 3584, PC_GB = 4608;
constexpr int LDAR = 1536;
constexpr int HFF = DFF / 2;
constexpr float EPS = 1e-6f, LOG2E = 1.4426950408889634f, QSCALE = 0.125f * 1.4426950408889634f;

constexpr size_t MiB = 1u << 20;
constexpr size_t WS_CTL = 0, CTL_ZERO_BYTES = 1 * MiB;
constexpr size_t WS_MOD = 1 * MiB;
constexpr size_t WS_BIASP = 1 * MiB + 832 * 1024;
constexpr size_t WS_WIN = 2 * MiB, WS_WUP = 13 * MiB, WS_WDN = 24 * MiB, WS_WOA = 30 * MiB, WS_WOR = 31 * MiB, WS_WOUT = 33 * MiB, WS_WRG = 35 * MiB, WS_WIG = 35 * MiB + 512 * 1024;
constexpr size_t WS_VT = 40 * MiB;
constexpr size_t WS_A = 64 * MiB;
constexpr size_t WS_ACT = WS_A + 352 * MiB;
constexpr size_t WS_B = 768 * MiB;
constexpr size_t WS_C = 896 * MiB;
constexpr size_t WS_END = 1024 * MiB;
static_assert(WS_MOD + (size_t)BATCH * NMOD * 4 <= WS_BIASP && WS_BIASP + LDP * 4 <= WS_WIN, "ws map");
static_assert(WS_WIN + (size_t)LDP * D * 2 <= WS_WUP && WS_WUP + (size_t)LDP * D * 2 <= WS_WDN && WS_WDN + (size_t)D * DFF * 2 <= WS_WOA, "ws map");
static_assert(WS_A + (size_t)M * LDP * 2 <= WS_B && WS_ACT + (size_t)M * DFF * 2 <= WS_B && WS_B + (size_t)M * D * 2 <= WS_C && WS_C + (size_t)M * D * 2 <= WS_END, "ws map");
constexpr int CW_TMO = 0, CW_CODE = 1, CW_BAR = 4096;

constexpr int RING_OFF = 0, RING_BYTES = 131072;
constexpr int LDSCTL_OFF = RING_BYTES, MISC_OFF = LDSCTL_OFF + 320;
constexpr int LDS_BYTES = 147456;


typedef unsigned u32x2 __attribute__((ext_vector_type(2)));
typedef float f32x16 __attribute__((ext_vector_type(16)));
struct Frame {
    LAS unsigned char* lds;
    volatile LAS unsigned* MISC;
    gu32* ctl;
    int tid, lane, wave;
    int vcu, G;
    const float *x, *c, *w_ada, *b_ada, *g_mix, *w_in, *b_in, *rel_bias, *conv_rnn_w, *conv_rnn_b, *w_rg, *b_rg, *w_ig, *b_ig, *lru_lambda,
                *w_o_attn, *w_o_rnn, *w_out, *g_ffn, *w_up, *conv_ffn_w, *conv_ffn_b, *w_down, *g_final;
    float* out;
    float *mod, *biasp;
    bf16 *Win_t, *Wup_t, *Wdn_t, *Woa_t, *Wor_t, *Wout_t, *Wrg_t, *Wig_t;
    bf16 *VT, *P, *UPH, *ACT, *XN, *T1, *MG, *AR;
};
__device__ __forceinline__ float bf2f_lo(unsigned u) { return __uint_as_float(u << 16); }
__device__ __forceinline__ float bf2f_hi(unsigned u) { return __uint_as_float(u & 0xffff0000u); }
__device__ __forceinline__ float bf1(bf16 v) { return __uint_as_float(((unsigned)v) << 16); }
typedef float f32x2_t __attribute__((ext_vector_type(2))); typedef __bf16 bf16x2_t __attribute__((ext_vector_type(2)));
__device__ __forceinline__ unsigned cvtpk(float lo, float hi) { f32x2_t v = {lo, hi}; bf16x2_t b = __builtin_convertvector(v, bf16x2_t); return __builtin_bit_cast(unsigned, b); }
__device__ __forceinline__ float wave_sum(float v) {
#pragma unroll
    for (int o = 1; o < 64; o <<= 1) v += __shfl_xor(v, o);
    return v;
}
__device__ __forceinline__ float sigmoidf_(float x) { return __builtin_amdgcn_rcpf(1.f + __builtin_amdgcn_exp2f(-LOG2E * x)); }

__device__ __forceinline__ void tr_item(const float* W, int ldw, int k0, int c0, int nvalid, bf16* WT, int ldt, int r0, LAS float* scr, int lane) {
#pragma unroll 8
    for (int i = 0; i < 32; ++i) { const int kk = 2 * i + (lane >> 5), n = lane & 31; scr[kk * 33 + n] = (n < nvalid) ? W[(size_t)(k0 + kk) * ldw + c0 + n] : 0.f; }
    LDS_WAIT(); asm volatile("" ::: "memory");
    const int c = lane & 7;
#pragma unroll
    for (int j = 0; j < 4; ++j) { const int n = (lane >> 3) + 8 * j; const LAS float* s = scr + (8 * c) * 33 + n;
        v4u o; o.x = pk2(s[0 * 33], s[1 * 33]); o.y = pk2(s[2 * 33], s[3 * 33]); o.z = pk2(s[4 * 33], s[5 * 33]); o.w = pk2(s[6 * 33], s[7 * 33]);
        *(GAS v4u*)(WT + (size_t)(r0 + n) * ldt + k0 + 8 * c) = o; }
    LDS_WAIT(); asm volatile("" ::: "memory");
}
__device__ __forceinline__ int proj_src_col(int d) { return d < 1352 ? d : (d >= 1536 ? d - 184 : -1); }

__device__ __forceinline__ void p0_prologue(Frame& F) {
    LAS float* scr = (LAS float*)(F.lds + RING_OFF + F.wave * 16384);
    const int gw = F.vcu * NWAVES + F.wave, NGW = F.G * NWAVES;
    constexpr int I_IN = 16 * 176, I_UP = 16 * 176, I_DN = 44 * 32, I_OA = 8 * 32, I_OR = 16 * 32, I_OUT = 16 * 32, I_RG = 64, I_IG = 64;
    constexpr int NITEMS = I_IN + I_UP + I_DN + I_OA + I_OR + I_OUT + I_RG + I_IG;
    for (int it = gw; it < NITEMS; it += NGW) {
        int r = it;
        if (r < I_IN) { const int kb = r / 176, d0 = 32 * (r % 176); int c0 = 0, nv = 32;
            if (d0 < 1344) c0 = d0; else if (d0 == 1344) { c0 = 1344; nv = 8; } else if (d0 < 1536) { c0 = 0; nv = 0; } else c0 = d0 - 184;
            tr_item(F.w_in, NIN, 64 * kb, c0, nv, F.Win_t, D, d0, scr, F.lane); continue; } r -= I_IN;
        if (r < I_UP) { const int kb = r / 176, d0 = 32 * (r % 176); const int seg = d0 / HFF, off = d0 - seg * HFF;
            const int c0 = (seg == 0) ? off : (seg == 1) ? DFF + off : (seg == 2) ? HFF + off : DFF + HFF + off;
            tr_item(F.w_up, 2 * DFF, 64 * kb, c0, 32, F.Wup_t, D, d0, scr, F.lane); continue; } r -= I_UP;
        if (r < I_DN) { const int kb = r / 32, nb = r % 32; tr_item(F.w_down, D, 64 * kb, 32 * nb, 32, F.Wdn_t, DFF, 32 * nb, scr, F.lane); continue; } r -= I_DN;
        if (r < I_OA) { const int kb = r / 32, nb = r % 32; tr_item(F.w_o_attn, D, 64 * kb, 32 * nb, 32, F.Woa_t, 512, 32 * nb, scr, F.lane); continue; } r -= I_OA;
        if (r < I_OR) { const int kb = r / 32, nb = r % 32; tr_item(F.w_o_rnn, D, 64 * kb, 32 * nb, 32, F.Wor_t, D, 32 * nb, scr, F.lane); continue; } r -= I_OR;
        if (r < I_OUT) { const int kb = r / 32, nb = r % 32; tr_item(F.w_out, D, 64 * kb, 32 * nb, 32, F.Wout_t, D, 32 * nb, scr, F.lane); continue; } r -= I_OUT;
        if (r < I_RG) { const int blk = r / 8, rr = r % 8, kb = rr / 4, nb = rr % 4; tr_item(F.w_rg + blk * 16384, 128, 64 * kb, 32 * nb, 32, F.Wrg_t + blk * 16384, 128, 32 * nb, scr, F.lane); continue; } r -= I_RG;
        { const int blk = r / 8, rr = r % 8, kb = rr / 4, nb = rr % 4; tr_item(F.w_ig + blk * 16384, 128, 64 * kb, 32 * nb, 32, F.Wig_t + blk * 16384, 128, 32 * nb, scr, F.lane); }
    }
    for (int d = F.vcu * (NWAVES * 64) + F.tid; d < LDP; d += F.G * NWAVES * 64) { const int s = proj_src_col(d); F.biasp[d] = (s >= 0) ? F.b_in[s] : 0.f; }
    __syncthreads();
    for (int item = F.vcu; item < NMOD / 64; item += F.G) {
        LAS float* cs = (LAS float*)(F.lds + RING_OFF);
        for (int i = F.tid; i < BATCH * D; i += NWAVES * 64) { const float v = F.c[i]; cs[i] = v * sigmoidf_(v); }
        __syncthreads();
        const int col = item * 64 + F.lane, kbase = F.wave * 128;
        float acc[BATCH];
#pragma unroll
        for (int b = 0; b < BATCH; ++b) acc[b] = 0.f;
        for (int k4 = 0; k4 < 32; ++k4) {
            const int k = kbase + 4 * k4;
            const float w0 = F.w_ada[(size_t)(k + 0) * NMOD + col], w1 = F.w_ada[(size_t)(k + 1) * NMOD + col], w2 = F.w_ada[(size_t)(k + 2) * NMOD + col], w3 = F.w_ada[(size_t)(k + 3) * NMOD + col];
#pragma unroll
            for (int b = 0; b < BATCH; ++b) { const f32x4 c4 = *(const LAS f32x4*)(cs + b * D + k); acc[b] += (c4.x * w0 + c4.y * w1) + (c4.z * w2 + c4.w * w3); }
        }
        __syncthreads();
        LAS float* red = (LAS float*)(F.lds + RING_OFF);
#pragma unroll
        for (int b = 0; b < BATCH; ++b) red[(F.wave * BATCH + b) * 64 + F.lane] = acc[b];
        __syncthreads();
        for (int o = F.tid; o < BATCH * 64; o += NWAVES * 64) { const int b = o >> 6, l = o & 63; float s = F.b_ada[item * 64 + l];
#pragma unroll
            for (int w = 0; w < NWAVES; ++w) s += red[(w * BATCH + b) * 64 + l];
            F.mod[(size_t)b * NMOD + item * 64 + l] = s; }
        __syncthreads();
    }
}

__device__ __forceinline__ void p_norm_mod(Frame& F, const float* src, bf16* dst, const float* g, int sh_off, int sc_off) {
    const int gw = F.vcu * NWAVES + F.wave, NGW = F.G * NWAVES;
    for (int rb = gw; rb < M / 32; rb += NGW) {
        const int b = rb / (SEQ / 32);
        const float* mb = F.mod + (size_t)b * NMOD;
        f32x4 gm[4], sh[4];
#pragma unroll
        for (int j = 0; j < 4; ++j) { const int col = 4 * F.lane + 256 * j; const f32x4 gg = *(const f32x4*)(g + col), sc = *(const f32x4*)(mb + sc_off + col); sh[j] = *(const f32x4*)(mb + sh_off + col); gm[j] = gg * (sc + 1.0f); }
        for (int r = 0; r < 32; ++r) {
            const size_t row = (size_t)rb * 32 + r;
            const GAS f32x4* xr = (const GAS f32x4*)(src + row * D) + F.lane;
            f32x4 v[4]; float s = 0.f;
#pragma unroll
            for (int j = 0; j < 4; ++j) { v[j] = xr[64 * j]; s += (v[j].x * v[j].x + v[j].y * v[j].y) + (v[j].z * v[j].z + v[j].w * v[j].w); }
            const float rstd = 1.0f / sqrtf(wave_sum(s) * (1.f / D) + EPS);
            GAS u32x2* o8 = (GAS u32x2*)(dst + row * D) + F.lane;
#pragma unroll
            for (int j = 0; j < 4; ++j) { const f32x4 o = v[j] * rstd * gm[j] + sh[j]; u32x2 w; w.x = cvtpk(o.x, o.y); w.y = cvtpk(o.z, o.w); o8[64 * j] = w; }
        }
    }
}
__device__ __forceinline__ void p_norm_final(Frame& F) {
    const int gw = F.vcu * NWAVES + F.wave, NGW = F.G * NWAVES;
    f32x4 gm[4];
#pragma unroll
    for (int j = 0; j < 4; ++j) gm[j] = *(const f32x4*)(F.g_final + 4 * F.lane + 256 * j);
    for (int rb = gw; rb < M / 32; rb += NGW)
        for (int r = 0; r < 32; ++r) {
            const size_t row = (size_t)rb * 32 + r;
            GAS f32x4* xr = (GAS f32x4*)(F.out + row * D) + F.lane;
            f32x4 v[4]; float s = 0.f;
#pragma unroll
            for (int j = 0; j < 4; ++j) { v[j] = xr[64 * j]; s += (v[j].x * v[j].x + v[j].y * v[j].y) + (v[j].z * v[j].z + v[j].w * v[j].w); }
            const float rstd = 1.0f / sqrtf(wave_sum(s) * (1.f / D) + EPS);
#pragma unroll
            for (int j = 0; j < 4; ++j) xr[64 * j] = v[j] * rstd * gm[j];
        }
}

__device__ __forceinline__ void p_act(Frame& F, int half) {
    constexpr int NCG = HFF / 8;
    const int T = F.vcu * (NWAVES * 64) + F.tid, NT = F.G * NWAVES * 64, nslots = NT / NCG;
    if (T >= nslots * NCG) return;
    const int cg = T % NCG, slot = T / NCG;
    const int j0 = cg * 8, jg = half * HFF + j0;
    float wv[3][8], wg[3][8], bv[8], bg[8];
#pragma unroll
    for (int k = 0; k < 3; ++k)
#pragma unroll
        for (int e = 0; e < 8; ++e) { wv[k][e] = F.conv_ffn_w[(size_t)k * (2 * DFF) + jg + e]; wg[k][e] = F.conv_ffn_w[(size_t)k * (2 * DFF) + DFF + jg + e]; }
#pragma unroll
    for (int e = 0; e < 8; ++e) { bv[e] = F.conv_ffn_b[jg + e]; bg[e] = F.conv_ffn_b[DFF + jg + e]; }
    for (int rc = slot; rc < M / 16; rc += nslots) {
        const size_t t0 = (size_t)rc * 16;
        const bool first = (t0 % SEQ) == 0;
        const bf16* up = F.UPH + t0 * DFF + j0;
        v4u v2 = {0, 0, 0, 0}, v1 = {0, 0, 0, 0}, g2 = {0, 0, 0, 0}, g1 = {0, 0, 0, 0};
        if (!first) { v2 = *(const v4u*)(up - 2 * (ptrdiff_t)DFF); v1 = *(const v4u*)(up - (ptrdiff_t)DFF); g2 = *(const v4u*)(up - 2 * (ptrdiff_t)DFF + HFF); g1 = *(const v4u*)(up - (ptrdiff_t)DFF + HFF); }
        bf16* ap = F.ACT + t0 * DFF + jg;
#pragma unroll 4
        for (int r = 0; r < 16; ++r) {
            const v4u v0 = *(const v4u*)(up + (size_t)r * DFF), g0 = *(const v4u*)(up + (size_t)r * DFF + HFF);
            float o[8];
#pragma unroll
            for (int q = 0; q < 4; ++q) {
                const unsigned a2 = v2[q], a1 = v1[q], a0 = v0[q], c2 = g2[q], c1 = g1[q], c0 = g0[q];
                const float vl = wv[0][2 * q] * bf2f_lo(a2) + wv[1][2 * q] * bf2f_lo(a1) + wv[2][2 * q] * bf2f_lo(a0) + bv[2 * q];
                const float vh = wv[0][2 * q + 1] * bf2f_hi(a2) + wv[1][2 * q + 1] * bf2f_hi(a1) + wv[2][2 * q + 1] * bf2f_hi(a0) + bv[2 * q + 1];
                const float gl = wg[0][2 * q] * bf2f_lo(c2) + wg[1][2 * q] * bf2f_lo(c1) + wg[2][2 * q] * bf2f_lo(c0) + bg[2 * q];
                const float gh = wg[0][2 * q + 1] * bf2f_hi(c2) + wg[1][2 * q + 1] * bf2f_hi(c1) + wg[2][2 * q + 1] * bf2f_hi(c0) + bg[2 * q + 1];
                o[2 * q] = gl * sigmoidf_(gl) * vl; o[2 * q + 1] = gh * sigmoidf_(gh) * vh;
            }
            v4u w; w.x = cvtpk(o[0], o[1]); w.y = cvtpk(o[2], o[3]); w.z = cvtpk(o[4], o[5]); w.w = cvtpk(o[6], o[7]);
            *(v4u*)(ap + (size_t)r * DFF) = w;
            v2 = v1; v1 = v0; g2 = g1; g1 = g0;
        }
    }
}

__constant__ unsigned char T5_BUCKET[128] = {
    0, 1, 2, 3, 4, 5, 6, 7, 8, 9, 10, 11, 12, 13, 14, 15, 16, 16, 16, 17, 17, 18, 18, 18, 19, 19, 19, 20, 20, 20, 20, 21, 21, 21, 21, 22, 22, 22, 22, 22,
    23, 23, 23, 23, 23, 23, 24, 24, 24, 24, 24, 24, 25, 25, 25, 25, 25, 25, 25, 26, 26, 26, 26, 26, 26, 26, 26, 27, 27, 27, 27, 27, 27, 27, 27, 27, 27,
    28, 28, 28, 28, 28, 28, 28, 28, 28, 28, 29, 29, 29, 29, 29, 29, 29, 29, 29, 29, 29, 29, 30, 30, 30, 30, 30, 30, 30, 30, 30, 30, 30, 30, 30, 30,
    31, 31, 31, 31, 31, 31, 31, 31, 31, 31, 31, 31, 31, 31, 31};
constexpr int ATT_MASK_OFF = 0;
constexpr int ATT_TBL_OFF = 16384;
constexpr int ATT_KI_OFF = 20480, ATT_KI_STRIDE = 144, ATT_KI_BUF = 64 * ATT_KI_STRIDE;
constexpr int ATT_K_OFF = 40960, ATT_K_STRIDE = 272, ATT_K_BUF = 64 * ATT_K_STRIDE;
constexpr int ATT_VT_OFF = ATT_K_OFF + 2 * ATT_K_BUF, ATT_VT_STRIDE = 136, ATT_VT_BUF = 128 * ATT_VT_STRIDE;
static_assert(ATT_VT_OFF + 2 * ATT_VT_BUF <= RING_BYTES && ATT_KI_OFF + 2 * ATT_KI_BUF <= ATT_K_OFF, "attention LDS map");
__device__ __forceinline__ unsigned ord_key(float s) { const unsigned u = __float_as_uint(s); return (u & 0x80000000u) ? ~u : (u | 0x80000000u); }
#define KEEP4(dep, a) asm volatile("" : "+v"(dep) : "v"((a)[0]), "v"((a)[1]), "v"((a)[2]), "v"((a)[3]))

__device__ __forceinline__ void attn_unit(Frame& F, int b, int qb) {
    const int tid = F.tid, w = F.wave;
    LAS unsigned char* L = F.lds + RING_OFF;
    LAS unsigned* maskL = (LAS unsigned*)(L + ATT_MASK_OFF);
    const LAS float* tbl = (const LAS float*)(L + ATT_TBL_OFF);
    const size_t tok0 = (size_t)b * SEQ;
    const int qw = qb * 64 + 8 * w;
    const int n64 = qb + 1;
    const GAS bf16* Pb = (const GAS bf16*)F.P + tok0 * LDP;

#ifndef NO_PASS1
    for (int tile = 0; tile < 2; ++tile) {
        int tidv = tid; asm volatile("" : "+v"(tidv));
        const int l32v = tidv & 31, gv = (tidv >> 5) & 1;
        int n64v = n64; asm volatile("" : "+s"(n64v));
        const GAS char* kisrc = (const GAS char*)Pb + ((size_t)(tidv >> 3) * LDP + PC_KI + 8 * (tidv & 7)) * 2;
        const int kidst = ATT_KI_OFF + (tidv >> 3) * ATT_KI_STRIDE + (tidv & 7) * 16;
        const int qq = 2 * ((l32v >> 2) & 1) + (l32v >> 4), hd = ((l32v >> 3) & 1) * 4 + (l32v & 3);
        const GAS bf16* qrow = Pb + (size_t)(qw + 4 * tile + qq) * LDP + PC_QI + hd * 64 + 8 * gv;
        bf16x8 af[4];
#pragma unroll
        for (int ks = 0; ks < 4; ++ks) af[ks] = *(const GAS bf16x8*)(qrow + 16 * ks);
        const int t0q = qw + 4 * tile + 2 * gv;
        float wq[2][8];
#pragma unroll
        for (int e = 0; e < 2; ++e) { const v4u wv = *(const GAS v4u*)(Pb + (size_t)(t0q + e) * LDP + PC_WI);
            wq[e][0] = bf2f_lo(wv.x); wq[e][1] = bf2f_hi(wv.x); wq[e][2] = bf2f_lo(wv.y); wq[e][3] = bf2f_hi(wv.y); wq[e][4] = bf2f_lo(wv.z); wq[e][5] = bf2f_hi(wv.z); wq[e][6] = bf2f_lo(wv.w); wq[e][7] = bf2f_hi(wv.w); }
        unsigned keys[64][2];
        { const v4u st = *(const GAS v4u*)kisrc; *(LAS v4u*)(L + kidst) = st; }
        __syncthreads();
        const int kfoff = ATT_KI_OFF + l32v * ATT_KI_STRIDE + 16 * gv;
#pragma unroll
        for (int t = 0; t < 32; ++t) {
            if (t < n64v) {
                v4u nx = {0u, 0u, 0u, 0u};
                if (t + 1 < n64v) nx = *(const GAS v4u*)(kisrc + (size_t)(t + 1) * (64 * LDP * 2));
#pragma unroll
                for (int j = 0; j < 2; ++j) {
                    const int kt = 2 * t + j;
                    const LAS unsigned char* fp = L + kfoff + (t & 1) * ATT_KI_BUF + j * 32 * ATT_KI_STRIDE;
                    bf16x8 bfr[4];
#pragma unroll
                    for (int ks = 0; ks < 4; ++ks) bfr[ks] = *(const LAS bf16x8*)(fp + 32 * ks);
                    f32x16 acc = {0.f, 0.f, 0.f, 0.f, 0.f, 0.f, 0.f, 0.f, 0.f, 0.f, 0.f, 0.f, 0.f, 0.f, 0.f, 0.f};
#pragma unroll
                    for (int ks = 0; ks < 4; ++ks) acc = __builtin_amdgcn_mfma_f32_32x32x16_bf16(af[ks], bfr[ks], acc, 0, 0, 0);
                    float s0 = 0.f, s1 = 0.f;
#pragma unroll
                    for (int r = 0; r < 8; ++r) { s0 += wq[0][r] * __builtin_amdgcn_fmed3f(acc[r], 0.f, __builtin_inff()); s1 += wq[1][r] * __builtin_amdgcn_fmed3f(acc[8 + r], 0.f, __builtin_inff()); }
                    KEEP4(s0, bfr);
                    const int sidx = 32 * kt + l32v; const unsigned low = 2047u - (unsigned)sidx;
                    keys[kt][0] = (sidx <= t0q) ? ((ord_key(s0) & 0xFFFFF800u) | low) : 0u;
                    keys[kt][1] = (sidx <= t0q + 1) ? ((ord_key(s1) & 0xFFFFF800u) | low) : 0u;
                }
                if (t + 1 < n64v) *(LAS v4u*)(L + kidst + ((t + 1) & 1) * ATT_KI_BUF) = nx;
                __syncthreads();
            } else { keys[2 * t][0] = 0u; keys[2 * t][1] = 0u; keys[2 * t + 1][0] = 0u; keys[2 * t + 1][1] = 0u; }
            __builtin_amdgcn_sched_barrier(0);
        }
        unsigned T0 = 0u, T1 = 0u; bool d0 = false, d1 = false;
        if (t0q + 1 <= NSEL) { T0 = 1u; d0 = true; }
        if (t0q + 2 <= NSEL) { T1 = 1u; d1 = true; }
        for (int bit = 31; bit >= 0; --bit) {
            if (__all(d0 && d1)) break;
            const unsigned c0 = T0 | (1u << bit), c1 = T1 | (1u << bit);
            unsigned cnt = 0u;
#pragma unroll
            for (int gq = 0; gq < 4; ++gq)
                if (8 * gq < n64v) {
#pragma unroll
                    for (int k2 = 0; k2 < 16; ++k2) { cnt += (keys[16 * gq + k2][0] >= c0) ? 1u : 0u; cnt += (keys[16 * gq + k2][1] >= c1) ? 0x10000u : 0u; }
                }
#pragma unroll
            for (int o = 1; o < 32; o <<= 1) cnt += __shfl_xor(cnt, o);
            const unsigned n0 = cnt & 0xffffu, n1 = cnt >> 16;
            if (!d0) { if (n0 >= (unsigned)NSEL) T0 = c0; if (n0 == (unsigned)NSEL) d0 = true; }
            if (!d1) { if (n1 >= (unsigned)NSEL) T1 = c1; if (n1 == (unsigned)NSEL) d1 = true; }
        }
        const int qloc = 8 * w + 4 * tile + 2 * gv;
#pragma unroll
        for (int kt = 0; kt < 64; ++kt)
            if (kt < 2 * n64v) {
                const unsigned long long b0 = __ballot(keys[kt][0] >= T0), b1 = __ballot(keys[kt][1] >= T1);
                if (l32v == 0) { maskL[(qloc + 0) * 64 + kt] = gv ? (unsigned)(b0 >> 32) : (unsigned)b0; maskL[(qloc + 1) * 64 + kt] = gv ? (unsigned)(b1 >> 32) : (unsigned)b1; }
            }
    }

#endif
#ifndef NO_PASS2
    {
        int tid2 = tid; asm volatile("" : "+v"(tid2));
        const int l32 = tid2 & 31, g = (tid2 >> 5) & 1;
        const int ql8 = l32 >> 2, hl = l32 & 3;
        const int tq = qw + ql8;
        const GAS bf16* qrow = Pb + (size_t)tq * LDP + PC_Q + 8 * g;
        bf16x8 qf[2][4];
#pragma unroll
        for (int gk = 0; gk < 2; ++gk)
#pragma unroll
            for (int ks = 0; ks < 4; ++ks) qf[gk][ks] = *(const GAS bf16x8*)(qrow + (4 * gk + hl) * 64 + 16 * ks);
        f32x16 O[2][2];
#pragma unroll
        for (int gk = 0; gk < 2; ++gk)
#pragma unroll
            for (int mt = 0; mt < 2; ++mt)
#pragma unroll
                for (int r = 0; r < 16; ++r) O[gk][mt][r] = 0.f;
        float lsum[2] = {0.f, 0.f}, mrun[2] = {0.f, 0.f};
        const float b31[2] = {tbl[hl * 128 + 127], tbl[(4 + hl) * 128 + 127]};
        const LAS unsigned* mrow = maskL + (8 * w + ql8) * 64;
        const GAS char* ksrc = (const GAS char*)Pb + ((size_t)(tid2 >> 4) * LDP + PC_K + 8 * (tid2 & 15)) * 2;
        const int kdst = ATT_K_OFF + (tid2 >> 4) * ATT_K_STRIDE + (tid2 & 15) * 16;
        const GAS char* vsrc = (const GAS char*)((const GAS bf16*)F.VT + (size_t)b * 128 * SEQ + (size_t)(tid2 >> 3) * SEQ + 8 * (tid2 & 7));
        const int vdst = ATT_VT_OFF + (tid2 >> 3) * ATT_VT_STRIDE + (tid2 & 7) * 16;
        v4u kx[2], vx[2];
#define ATT_LOAD(t_) do { kx[0] = *(const GAS v4u*)(ksrc + (size_t)(t_) * (64 * LDP * 2)); kx[1] = *(const GAS v4u*)(ksrc + (size_t)(t_) * (64 * LDP * 2) + (size_t)32 * LDP * 2); \
        vx[0] = *(const GAS v4u*)(vsrc + (size_t)(t_) * 128); vx[1] = *(const GAS v4u*)(vsrc + (size_t)(t_) * 128 + (size_t)64 * SEQ * 2); } while (0)
#define ATT_STORE(buf_) do { *(LAS v4u*)(L + kdst + (buf_) * ATT_K_BUF) = kx[0]; *(LAS v4u*)(L + kdst + (buf_) * ATT_K_BUF + 32 * ATT_K_STRIDE) = kx[1]; \
        *(LAS u32x2*)(L + vdst + (buf_) * ATT_VT_BUF) = (u32x2){vx[0].x, vx[0].y}; *(LAS u32x2*)(L + vdst + (buf_) * ATT_VT_BUF + 8) = (u32x2){vx[0].z, vx[0].w}; \
        *(LAS u32x2*)(L + vdst + (buf_) * ATT_VT_BUF + 64 * ATT_VT_STRIDE) = (u32x2){vx[1].x, vx[1].y}; *(LAS u32x2*)(L + vdst + (buf_) * ATT_VT_BUF + 64 * ATT_VT_STRIDE + 8) = (u32x2){vx[1].z, vx[1].w}; } while (0)
        ATT_LOAD(0); ATT_STORE(0);
        __syncthreads();
        const int kfo = ATT_K_OFF + l32 * ATT_K_STRIDE + 16 * g;
        const int vfo = ATT_VT_OFF + l32 * ATT_VT_STRIDE + 8 * g;
        for (int t = 0; t < n64; ++t) {
            if (t + 1 < n64) ATT_LOAD(t + 1);
            const int bufk = (t & 1) * ATT_K_BUF, bufv = (t & 1) * ATT_VT_BUF;
            bf16x8 pf[2]; pf[0] = (bf16x8){0, 0, 0, 0, 0, 0, 0, 0}; pf[1] = pf[0];
#pragma unroll
            for (int i = 0; i < 5; ++i) {
                const int j = (i >> 1) & 1, gk = i & 1, jp = ((i - 1) >> 1) & 1, gp = (i - 1) & 1;
                __builtin_amdgcn_sched_barrier(0);
                bf16x8 vf[2][2], kf[4];
                if (i > 0) {
#pragma unroll
                    for (int mt = 0; mt < 2; ++mt)
#pragma unroll
                        for (int s = 0; s < 2; ++s) { const LAS unsigned char* vp = L + vfo + bufv + (gp * 64 + 32 * mt) * ATT_VT_STRIDE + jp * 64 + 32 * s;
                            const u32x2 lo = *(const LAS u32x2*)vp, hi = *(const LAS u32x2*)(vp + 16); v4u vv = {lo.x, lo.y, hi.x, hi.y}; vf[mt][s] = __builtin_bit_cast(bf16x8, vv); }
                }
                if (i < 4) {
#pragma unroll
                    for (int ks = 0; ks < 4; ++ks) kf[ks] = *(const LAS bf16x8*)(L + kfo + bufk + j * 32 * ATT_K_STRIDE + gk * 128 + 32 * ks);
                }
                if (i > 0) {
#pragma unroll
                    for (int s = 0; s < 2; ++s)
#pragma unroll
                        for (int mt = 0; mt < 2; ++mt) O[gp][mt] = __builtin_amdgcn_mfma_f32_32x32x16_bf16(vf[mt][s], pf[s], O[gp][mt], 0, 0, 0);
                }
                if (i < 4) {
                    const int kt = 2 * t + j;
                    f32x16 S = {0.f, 0.f, 0.f, 0.f, 0.f, 0.f, 0.f, 0.f, 0.f, 0.f, 0.f, 0.f, 0.f, 0.f, 0.f, 0.f};
#pragma unroll
                    for (int ks = 0; ks < 4; ++ks) S = __builtin_amdgcn_mfma_f32_32x32x16_bf16(kf[ks], qf[gk][ks], S, 0, 0, 0);
                    const unsigned mg = mrow[kt] >> (4 * g);
                    const bool far = (qw - (32 * kt + 31)) >= 113;
                    float x[16];
                    if (far) { const float cb = b31[gk] - mrun[gk];
#pragma unroll
                        for (int r = 0; r < 16; ++r) x[r] = S[r] + cb;
                    } else { const LAS float* tb = tbl + (4 * gk + hl) * 128; int dbase = tq - 32 * kt - 4 * g; asm volatile("" : "+v"(dbase)); const float mr = mrun[gk];
#pragma unroll
                        for (int r = 0; r < 16; ++r) { int dd = dbase - ((r & 3) + 8 * (r >> 2)); dd = dd < 0 ? 0 : (dd > 127 ? 127 : dd); x[r] = S[r] + (tb[dd] - mr); }
                    }
                    KEEP4(x[0], kf);
                    if (i > 0) asm volatile("" : "+v"(x[0]) : "v"(vf[0][0]), "v"(vf[0][1]), "v"(vf[1][0]), "v"(vf[1][1]), "v"(pf[0]), "v"(pf[1]));
                    float tm = x[0];
#pragma unroll
                    for (int r = 1; r < 16; ++r) tm = fmaxf(tm, x[r]);
                    tm = fmaxf(tm, __shfl_xor(tm, 32));
                    if (kt == 0) { mrun[gk] = tm;
#pragma unroll
                        for (int r = 0; r < 16; ++r) x[r] -= tm;
                    } else if (__any(tm > 8.f)) {
                        const float dl = fmaxf(tm, 0.f), alpha = __builtin_amdgcn_exp2f(-dl);
                        mrun[gk] += dl; lsum[gk] *= alpha;
#pragma unroll
                        for (int r = 0; r < 16; ++r) x[r] -= dl;
#pragma unroll
                        for (int mt = 0; mt < 2; ++mt)
#pragma unroll
                            for (int r = 0; r < 16; ++r) O[gk][mt][r] *= alpha;
                    }
                    float ps = 0.f; unsigned pk[8];
#pragma unroll
                    for (int r = 0; r < 16; r += 2) {
                        const int bp0 = 8 * (r >> 2) + (r & 3), bp1 = 8 * ((r + 1) >> 2) + ((r + 1) & 3);
                        const unsigned sm0 = (unsigned)(((int)(mg << (31 - bp0))) >> 31), sm1 = (unsigned)(((int)(mg << (31 - bp1))) >> 31);
                        const float p0 = __uint_as_float(__float_as_uint(__builtin_amdgcn_exp2f(x[r])) & sm0), p1 = __uint_as_float(__float_as_uint(__builtin_amdgcn_exp2f(x[r + 1])) & sm1);
                        ps += p0 + p1; pk[r >> 1] = cvtpk(p0, p1);
                    }
                    lsum[gk] += ps;
                    { v4u t0 = {pk[0], pk[1], pk[2], pk[3]}, t1 = {pk[4], pk[5], pk[6], pk[7]}; pf[0] = __builtin_bit_cast(bf16x8, t0); pf[1] = __builtin_bit_cast(bf16x8, t1); }
                    if (i == 0 && t + 1 < n64) ATT_STORE((t + 1) & 1);
                } else {
                    __builtin_amdgcn_sched_barrier(0);
                    asm volatile("s_nop 15"); asm volatile("s_nop 15"); asm volatile("s_nop 15"); asm volatile("s_nop 15");
                    asm volatile("s_nop 15"); asm volatile("s_nop 15"); asm volatile("s_nop 15"); asm volatile("s_nop 15");
                    asm volatile("" :: "v"(vf[0][0]), "v"(vf[0][1]), "v"(vf[1][0]), "v"(vf[1][1]), "v"(pf[0]), "v"(pf[1]));
                    __builtin_amdgcn_sched_barrier(0);
                }
            }
            __syncthreads();
        }
#undef ATT_LOAD
#undef ATT_STORE
        bf16* orow = F.AR + (tok0 + tq) * LDAR;
#pragma unroll
        for (int gk = 0; gk < 2; ++gk) {
            const float lt = lsum[gk] + __shfl_xor(lsum[gk], 32), inv = 1.0f / lt;
#pragma unroll
            for (int mt = 0; mt < 2; ++mt)
#pragma unroll
                for (int i = 0; i < 4; ++i) { const int d = 32 * mt + 8 * i + 4 * g;
                    u32x2 wv; wv.x = cvtpk(O[gk][mt][4 * i] * inv, O[gk][mt][4 * i + 1] * inv); wv.y = cvtpk(O[gk][mt][4 * i + 2] * inv, O[gk][mt][4 * i + 3] * inv);
                    *(u32x2*)(orow + (4 * gk + hl) * 64 + d) = wv; }
        }
    }
#endif
}

constexpr int LRU_XCF = 0, LRU_ABF = 32768, LRU_ABF_STRIDE = 272, LRU_RAW = 51200, LRU_GY = 69632, LRU_OUT = 86016;
__device__ __forceinline__ void lru_unit(Frame& F, int b, int n) {
    const int tid = F.tid, lane = F.lane, w = F.wave, l16 = lane & 15, q = lane >> 4;
    LAS unsigned char* L = F.lds + RING_OFF;
    LAS float* XCF = (LAS float*)(L + LRU_XCF);
    LAS unsigned char* ABF = L + LRU_ABF;
    LAS bf16* RAW = (LAS bf16*)(L + LRU_RAW);
    LAS bf16* GY = (LAS bf16*)(L + LRU_GY);
    LAS bf16* OUTS = (LAS bf16*)(L + LRU_OUT);
    const size_t tok0 = (size_t)b * SEQ;
    const bf16* Pb = F.P + tok0 * LDP;
    const int ch0 = n * 128;
    bf16x8 brg[4], big[4];
    { const bf16* wr = F.Wrg_t + (size_t)n * 16384 + (16 * w + l16) * 128 + 8 * q; const bf16* wi = F.Wig_t + (size_t)n * 16384 + (16 * w + l16) * 128 + 8 * q;
#pragma unroll
      for (int ks = 0; ks < 4; ++ks) { brg[ks] = *(const bf16x8*)(wr + 32 * ks); big[ks] = *(const bf16x8*)(wi + 32 * ks); } }
    const int dch = ch0 + 16 * w + l16;
    const float brg_b = F.b_rg[dch], big_b = F.b_ig[dch];
    const float lam = F.lru_lambda[dch];
    const float sp = fmaxf(-lam, 0.f) + log1pf(expf(-fabsf(lam)));
    const float a_coef = -8.0f * sp;
    const int cc = tid & 127, tseg = tid >> 7;
    const float cw0 = F.conv_rnn_w[0 * D + ch0 + cc], cw1 = F.conv_rnn_w[1 * D + ch0 + cc], cw2 = F.conv_rnn_w[2 * D + ch0 + cc], cw3 = F.conv_rnn_w[3 * D + ch0 + cc], cbias = F.conv_rnn_b[ch0 + cc];
    float hprev = 0.f;
    v4u raw[3], gyr[2];
#define LRU_LOAD(t0_) do { _Pragma("unroll") for (int i_ = 0; i_ < 3; ++i_) { const int idx_ = tid + 512 * i_; raw[i_] = (v4u){0u, 0u, 0u, 0u}; \
            if (idx_ < 67 * 16) { const int row_ = idx_ >> 4, part_ = idx_ & 15, t_ = (t0_) - 3 + row_; if (t_ >= 0) raw[i_] = *(const v4u*)(Pb + (size_t)t_ * LDP + PC_XR + ch0 + 8 * part_); } } \
        _Pragma("unroll") for (int i_ = 0; i_ < 2; ++i_) { const int idx_ = tid + 512 * i_, row_ = idx_ >> 4, part_ = idx_ & 15; gyr[i_] = *(const v4u*)(Pb + (size_t)((t0_) + row_) * LDP + PC_YR + ch0 + 8 * part_); } } while (0)
    LRU_LOAD(0);
    for (int chunk = 0; chunk < SEQ / 64; ++chunk) {
        const int t0 = chunk * 64;
#pragma unroll
        for (int i = 0; i < 3; ++i) { const int idx = tid + 512 * i; if (idx < 67 * 16) *(LAS v4u*)(RAW + idx * 8) = raw[i]; }
#pragma unroll
        for (int i = 0; i < 2; ++i) { const int idx = tid + 512 * i; *(LAS v4u*)(GY + idx * 8) = gyr[i]; }
        __syncthreads();
        if (chunk + 1 < SEQ / 64) LRU_LOAD(t0 + 64);
        { float x0 = bf1(RAW[(16 * tseg + 0) * 128 + cc]), x1 = bf1(RAW[(16 * tseg + 1) * 128 + cc]), x2 = bf1(RAW[(16 * tseg + 2) * 128 + cc]);
#pragma unroll
          for (int tt = 0; tt < 16; ++tt) { const int t = 16 * tseg + tt; const float x3 = bf1(RAW[(t + 3) * 128 + cc]);
              const float xc = cbias + cw0 * x0 + cw1 * x1 + cw2 * x2 + cw3 * x3;
              XCF[t * 128 + cc] = xc; *(LAS bf16*)(ABF + t * LRU_ABF_STRIDE + cc * 2) = (bf16)f2bf(xc);
              x0 = x1; x1 = x2; x2 = x3; } }
        __syncthreads();
#pragma unroll 1
        for (int rt = 0; rt < 4; ++rt) {
            f32x4 accR = {0.f, 0.f, 0.f, 0.f}, accI = {0.f, 0.f, 0.f, 0.f};
            const LAS unsigned char* ap = ABF + (16 * rt + l16) * LRU_ABF_STRIDE + 16 * q;
#pragma unroll
            for (int ks = 0; ks < 4; ++ks) { const bf16x8 af = *(const LAS bf16x8*)(ap + 64 * ks);
                accR = __builtin_amdgcn_mfma_f32_16x16x32_bf16(af, brg[ks], accR, 0, 0, 0); accI = __builtin_amdgcn_mfma_f32_16x16x32_bf16(af, big[ks], accI, 0, 0, 0); }
            float Ap[4], Hl[4];
#pragma unroll
            for (int r = 0; r < 4; ++r) { const int tt = 16 * rt + 4 * q + r; const float xc = XCF[tt * 128 + 16 * w + l16];
                const float rr = sigmoidf_(accR[r] + brg_b), ii = sigmoidf_(accI[r] + big_b);
                const float la = a_coef * rr, a = expf(la), mult = sqrtf(-expm1f(2.0f * la)), u = xc * ii * mult;
                if (r == 0) { Ap[0] = a; Hl[0] = u; } else { Ap[r] = Ap[r - 1] * a; Hl[r] = a * Hl[r - 1] + u; } }
            float A = Ap[3], H = Hl[3];
            { const float Au = __shfl_up(A, 16), Hu = __shfl_up(H, 16); if (q >= 1) { H = A * Hu + H; A = A * Au; } }
            { const float Au = __shfl_up(A, 32), Hu = __shfl_up(H, 32); if (q >= 2) { H = A * Hu + H; A = A * Au; } }
            float Ae = __shfl_up(A, 16), He = __shfl_up(H, 16); if (q == 0) { Ae = 1.f; He = 0.f; }
            const float hin = He + Ae * hprev;
            const float A3 = __shfl(A, 48 + l16), H3 = __shfl(H, 48 + l16);
            hprev = H3 + A3 * hprev;
#pragma unroll
            for (int r = 0; r < 4; ++r) { const int tt = 16 * rt + 4 * q + r; const float h = Hl[r] + Ap[r] * hin; const float gv = bf1(GY[tt * 128 + 16 * w + l16]);
                OUTS[tt * 128 + 16 * w + l16] = (bf16)f2bf(h * gv); }
        }
        __syncthreads();
#pragma unroll
        for (int i = 0; i < 2; ++i) { const int idx = tid + 512 * i, row = idx >> 4, part = idx & 15;
            *(v4u*)(F.AR + (tok0 + t0 + row) * LDAR + 512 + ch0 + 8 * part) = *(const LAS v4u*)(OUTS + idx * 8); }
    }
#undef LRU_LOAD
}

__device__ __forceinline__ void p3_mixers(Frame& F) {
    { LAS float* tbl = (LAS float*)(F.lds + RING_OFF + ATT_TBL_OFF);
      for (int i = F.tid; i < 8 * 128; i += NWAVES * 64) { const int h = i >> 7, d = i & 127; tbl[i] = F.rel_bias[(int)T5_BUCKET[d] * NH + h] * LOG2E; } }
    __syncthreads();
    for (int e = F.vcu; e < 1024; e += F.G) {
        const int k = e >> 8, r = e & 255, b = r >> 3, j = r & 7;
        const int qb = (k == 0) ? 31 - j : (k == 1) ? 16 + j : (k == 2) ? 15 - j : j;
#ifndef NO_ATT
        attn_unit(F, b, qb);
#else
        for (int i = F.tid; i < 64 * 64; i += NWAVES * 64) { const int row = i >> 6, part = i & 63; *(v4u*)(F.AR + ((size_t)b * SEQ + qb * 64 + row) * LDAR + 8 * part) = (v4u){0u, 0u, 0u, 0u}; }
#endif
    }
    __syncthreads();
#ifndef NO_LRU
    for (int u = F.vcu; u < BATCH * 8; u += F.G) lru_unit(F, u >> 3, u & 7);
#ifdef DUP_LRU
    __syncthreads();
    for (int u = F.vcu; u < BATCH * 8; u += F.G) lru_unit(F, u >> 3, u & 7);
#endif
#else
    for (int u = F.vcu; u < BATCH * 8; u += F.G) { const int b = u >> 3, n = u & 7;
        for (int i = F.tid; i < SEQ * 16; i += NWAVES * 64) { const int row = i >> 4, part = i & 15; *(v4u*)(F.AR + ((size_t)b * SEQ + row) * LDAR + 512 + n * 128 + 8 * part) = (v4u){0u, 0u, 0u, 0u}; } }
#endif
}

#ifndef MK_N_LAUNCHES
#define MK_N_LAUNCHES 1
#endif
constexpr int N_PHASES = 14;

#define CAS __attribute__((address_space(4)))
__device__ __forceinline__ void frame_ptrs(Frame& F) {
    const CAS unsigned long long* kp = (const CAS unsigned long long*)__builtin_amdgcn_kernarg_segment_ptr();
    asm volatile("" : "+s"(kp));
    { int t_ = threadIdx.x; asm volatile("" : "+v"(t_)); F.tid = t_; F.lane = t_ & 63; }
#define KIN(k) ((const float*)(const GAS float*)kp[k])
    F.x = KIN(0); F.c = KIN(1); F.w_ada = KIN(2); F.b_ada = KIN(3); F.g_mix = KIN(4); F.w_in = KIN(5); F.b_in = KIN(6); F.rel_bias = KIN(7);
    F.conv_rnn_w = KIN(8); F.conv_rnn_b = KIN(9); F.w_rg = KIN(10); F.b_rg = KIN(11); F.w_ig = KIN(12); F.b_ig = KIN(13); F.lru_lambda = KIN(14);
    F.w_o_attn = KIN(15); F.w_o_rnn = KIN(16); F.w_out = KIN(17); F.g_ffn = KIN(18); F.w_up = KIN(19); F.conv_ffn_w = KIN(20); F.conv_ffn_b = KIN(21);
    F.w_down = KIN(22); F.g_final = KIN(23);
#undef KIN
    F.out = (float*)(GAS float*)kp[24];
    GAS unsigned char* ws = (GAS unsigned char*)kp[25];
    F.mod = (float*)(ws + WS_MOD); F.biasp = (float*)(ws + WS_BIASP);
    F.Win_t = (bf16*)(ws + WS_WIN); F.Wup_t = (bf16*)(ws + WS_WUP); F.Wdn_t = (bf16*)(ws + WS_WDN); F.Woa_t = (bf16*)(ws + WS_WOA); F.Wor_t = (bf16*)(ws + WS_WOR); F.Wout_t = (bf16*)(ws + WS_WOUT);
    F.Wrg_t = (bf16*)(ws + WS_WRG); F.Wig_t = (bf16*)(ws + WS_WIG);
    F.VT = (bf16*)(ws + WS_VT); F.P = (bf16*)(ws + WS_A); F.UPH = (bf16*)(ws + WS_A); F.ACT = (bf16*)(ws + WS_ACT); F.XN = (bf16*)(ws + WS_B); F.T1 = (bf16*)(ws + WS_B); F.MG = (bf16*)(ws + WS_C);
    F.AR = (bf16*)(GAS bf16*)kp[24];
}
struct Args { const float* in[24]; float* out; unsigned char* ws; int ph_lo, ph_hi; };
__global__ void __launch_bounds__(NWAVES * 64, 2) mk_fwd(Args args) {
    extern __shared__ __attribute__((aligned(16))) unsigned char lds[];
    Frame F;
    F.lds = (LAS unsigned char*)lds;
    F.MISC = (volatile LAS unsigned*)(F.lds + MISC_OFF);
    F.tid = threadIdx.x; F.lane = F.tid & 63; F.wave = __builtin_amdgcn_readfirstlane(F.tid >> 6);
    F.G = gridDim.x; { const int bx = blockIdx.x; F.vcu = (F.G % 8 == 0) ? (bx % 8) * (F.G / 8) + bx / 8 : bx; }
    F.ctl = (gu32*)(args.ws + WS_CTL);
    for (int u = F.tid; u < (LDS_BYTES - LDSCTL_OFF) / 4; u += NWAVES * 64) ((LAS unsigned*)(F.lds + LDSCTL_OFF))[u] = 0u;
    __syncthreads();
    const int lo = args.ph_lo, hi = args.ph_hi;
    XcdBarrier bar; bar.bar = (unsigned*)(F.ctl + CW_BAR); bar.x = 0; bar.st = nullptr;
    if (hi - lo > 1) bar = xcd_barrier_post((unsigned*)(F.ctl + CW_BAR), F.MISC + 8);
#ifndef PHASE_MASK
#define PHASE_MASK 0xFFFFu
#endif
#define IN(k) (((PHASE_MASK >> (k)) & 1u) && lo <= (k) && (k) < hi)
#ifndef DUP_MASK
#define DUP_MASK 0u
#endif
#define REP(k) for (int rep_ = 0; rep_ < ((((DUP_MASK) >> (k)) & 1u) ? 2 : 1); ++rep_)
#define SEAM(k) do { if (IN(k) && IN((k) + 1)) xcd_barrier(bar); } while (0)
    typedef pg8::bf16_t gb;

    if (IN(0)) REP(0) { if (rep_) __syncthreads(); frame_ptrs(F); p0_prologue(F); } SEAM(0);
    if (IN(1)) REP(1) { if (rep_) __syncthreads(); frame_ptrs(F); p_norm_mod(F, F.x, F.XN, F.g_mix, 0 * D, 1 * D); } SEAM(1);
    if (IN(2)) REP(2) { if (rep_) __syncthreads(); frame_ptrs(F);
        pg8::Gemm g{(const gb*)F.XN, (const gb*)F.Win_t, M, LDP, D, D, D}; pg8::StaticOrder S; S.init(M, LDP, F.G, (int)blockIdx.x);
        pg8::EpiProj E{(gb*)F.P, LDP, F.biasp, (gb*)F.VT, SEQ, QSCALE};
        pg8::gemm_phase<pg8::EpiProj, pg8::StaticOrder, true, true>(F.lds + RING_OFF, g, S, E);
    } SEAM(2);
    if (IN(3)) REP(3) { if (rep_) __syncthreads(); frame_ptrs(F); p3_mixers(F); } SEAM(3);
    if (IN(4)) REP(4) { if (rep_) __syncthreads(); frame_ptrs(F);
        pg8::Gemm g{(const gb*)F.AR, (const gb*)F.Woa_t, M, D, 512, LDAR, 512}; pg8::StaticOrder S; S.init(M, D, F.G, (int)blockIdx.x);
        pg8::EpiGate<false> E{(const gb*)F.P + PC_GA, LDP, nullptr, (gb*)F.T1, D};
        pg8::gemm_phase<pg8::EpiGate<false>, pg8::StaticOrder, true, true>(F.lds + RING_OFF, g, S, E);
    } SEAM(4);
    if (IN(5)) REP(5) { if (rep_) __syncthreads(); frame_ptrs(F);
        pg8::Gemm g{(const gb*)F.AR + 512, (const gb*)F.Wor_t, M, D, D, LDAR, D}; pg8::StaticOrder S; S.init(M, D, F.G, (int)blockIdx.x);
        pg8::EpiGate<true> E{(const gb*)F.P + PC_GB, LDP, (const gb*)F.T1, (gb*)F.MG, D};
        pg8::gemm_phase<pg8::EpiGate<true>, pg8::StaticOrder, true, true>(F.lds + RING_OFF, g, S, E);
    } SEAM(5);
    if (IN(6)) REP(6) { if (rep_) __syncthreads(); frame_ptrs(F);
        pg8::Gemm g{(const gb*)F.MG, (const gb*)F.Wout_t, M, D, D, D, D}; pg8::StaticOrder S; S.init(M, D, F.G, (int)blockIdx.x);
        pg8::EpiResid E{F.x, F.out, D, F.mod + 2 * D, NMOD, SEQ};
        pg8::gemm_phase<pg8::EpiResid, pg8::StaticOrder, true, true>(F.lds + RING_OFF, g, S, E);
    } SEAM(6);
    if (IN(7)) REP(7) { if (rep_) __syncthreads(); frame_ptrs(F); p_norm_mod(F, F.out, F.XN, F.g_ffn, 3 * D, 4 * D); } SEAM(7);
    if (IN(8)) REP(8) { if (rep_) __syncthreads(); frame_ptrs(F);
        pg8::Gemm g{(const gb*)F.XN, (const gb*)F.Wup_t, M, DFF, D, D, D}; pg8::StaticOrder S; S.init(M, DFF, F.G, (int)blockIdx.x);
        pg8::EpiBf16Plain E{(gb*)F.UPH, DFF};
        pg8::gemm_phase<pg8::EpiBf16Plain, pg8::StaticOrder, true, true>(F.lds + RING_OFF, g, S, E);
    } SEAM(8);
    if (IN(9)) REP(9) { if (rep_) __syncthreads(); frame_ptrs(F); p_act(F, 0); } SEAM(9);
    if (IN(10)) REP(10) { if (rep_) __syncthreads(); frame_ptrs(F);
        pg8::Gemm g{(const gb*)F.XN, (const gb*)F.Wup_t + (size_t)DFF * D, M, DFF, D, D, D}; pg8::StaticOrder S; S.init(M, DFF, F.G, (int)blockIdx.x);
        pg8::EpiBf16Plain E{(gb*)F.UPH, DFF};
        pg8::gemm_phase<pg8::EpiBf16Plain, pg8::StaticOrder, true, true>(F.lds + RING_OFF, g, S, E);
    } SEAM(10);
    if (IN(11)) REP(11) { if (rep_) __syncthreads(); frame_ptrs(F); p_act(F, 1); } SEAM(11);
    if (IN(12)) REP(12) { if (rep_) __syncthreads(); frame_ptrs(F);
        pg8::Gemm g{(const gb*)F.ACT, (const gb*)F.Wdn_t, M, D, DFF, DFF, DFF}; pg8::StaticOrder S; S.init(M, D, F.G, (int)blockIdx.x);
        pg8::EpiResid E{F.out, F.out, D, F.mod + 5 * D, NMOD, SEQ};
        pg8::gemm_phase<pg8::EpiResid, pg8::StaticOrder, true, true>(F.lds + RING_OFF, g, S, E);
    } SEAM(12);
    if (IN(13)) REP(13) { if (rep_) __syncthreads(); frame_ptrs(F); p_norm_final(F); }
#undef IN
#undef SEAM
}

extern "C" void kernel_launch(void* const* d_in, const int* in_sizes, int n_in, void* d_out, int out_size, void* d_ws, size_t ws_size, hipStream_t stream) {
    static int grid = 0;
    if (grid == 0) {
        if (n_in != 24 || in_sizes[0] != M * D || out_size != M * D || ws_size < WS_END) { fprintf(stderr, "kernel_launch: unexpected shapes (n_in %d, in0 %d, out %d, ws %zu); nothing launched\n", n_in, n_in > 0 ? in_sizes[0] : -1, out_size, ws_size); grid = -1; return; }
        int dev = 0, cus = 0, per_cu = 0;
        if (hipGetDevice(&dev) != hipSuccess || hipDeviceGetAttribute(&cus, hipDeviceAttributeMultiprocessorCount, dev) != hipSuccess) { grid = -1; return; }
        if (hipFuncSetAttribute((const void*)mk_fwd, hipFuncAttributeMaxDynamicSharedMemorySize, LDS_BYTES) != hipSuccess) { fprintf(stderr, "kernel_launch: hipFuncSetAttribute failed\n"); grid = -1; return; }
        if (hipOccupancyMaxActiveBlocksPerMultiprocessor(&per_cu, (const void*)mk_fwd, NWAVES * 64, LDS_BYTES) != hipSuccess || per_cu < 1) { fprintf(stderr, "kernel_launch: occupancy query reports %d blocks per CU\n", per_cu); }
        (void)hipGetLastError();
        grid = cus;
    }
    if (grid < 0) return;
    if (hipMemsetAsync((char*)d_ws + WS_CTL, 0, CTL_ZERO_BYTES, stream) != hipSuccess) { fprintf(stderr, "kernel_launch: memset failed\n"); return; }
    Args a{};
    for (int i = 0; i < 24; ++i) a.in[i] = (const float*)d_in[i];
    a.out = (float*)d_out; a.ws = (unsigned char*)d_ws;
#if MK_N_LAUNCHES == 1
    a.ph_lo = 0; a.ph_hi = N_PHASES;
    hipLaunchKernelGGL(mk_fwd, dim3(grid), dim3(NWAVES * 64), LDS_BYTES, stream, a);
#else
    for (int p = 0; p < N_PHASES; ++p) { a.ph_lo = p; a.ph_hi = p + 1; hipLaunchKernelGGL(mk_fwd, dim3(grid), dim3(NWAVES * 64), LDS_BYTES, stream, a); }
#endif
    const hipError_t le = hipPeekAtLastError();
    if (le != hipSuccess) fprintf(stderr, "kernel_launch: launch failed: %s\n", hipGetErrorName(le));
}
```

```cpp
#define MK_N_LAUNCHES 1
#include <hip/hip_runtime.h>
#include <cstdio>
#include <cstdint>
namespace pg8 {
#define PG8_LAS __attribute__((address_space(3)))
typedef unsigned short bf16_t;
typedef short bf16x8 __attribute__((ext_vector_type(8)));
typedef float f32x4 __attribute__((ext_vector_type(4)));
typedef unsigned u32x4 __attribute__((ext_vector_type(4)));
constexpr int BM = 256, BK = 64, HALF = 128, HTB = HALF * BK * 2  , STAGE_BYTES = 8 * HTB, NXCD = 8, WGM = 8;

__host__ __device__ __forceinline__ int lds_byte(int r, int c) { const int st = (r >> 4) * 2 + (c >> 5), rr = r & 15, cc = c & 31, ob = rr * 64 + cc * 2; return st * 1024 + (ob ^ (((ob >> 9) & 1) << 5)); }
__host__ __device__ __forceinline__ void stage_rc(int b, int& R, int& C) { const int st = b / 1024, sb = b % 1024, swz = sb ^ (((sb >> 9) & 1) << 5); R = (st >> 1) * 16 + swz / 64; C = (st & 1) * 32 + (swz % 64) / 2; }
__host__ __device__ __forceinline__ int perm32(int rho) { const int n = rho >> 4, i = rho & 15; return 8 * (i >> 2) + 4 * n + (i & 3); }

struct Unit { int pm, pn; };
struct Gemm { const bf16_t* A; const bf16_t* Bt; int M, N, K, lda, ldb; };

struct StaticOrder {
    int nM, nN, nwg, G, c;
    __host__ __device__ void init(int M, int N, int G_, int c_) { nM = M / BM; nN = N / BM; nwg = nM * nN; G = G_; c = c_; }
    __host__ __device__ bool next(int i, Unit& u) const {
        const long L = (long)i * G + c; if (L >= nwg) return false;
        int wgid = (int)L; { const int q = nwg / NXCD, r = nwg % NXCD, xcd = wgid % NXCD, off = wgid / NXCD; wgid = (xcd < r ? xcd * (q + 1) : r * (q + 1) + (xcd - r) * q) + off; }
        const int nig = WGM * nN, gid = wgid / nig, fm = gid * WGM, gsz = (nM - fm) < WGM ? (nM - fm) : WGM;
        u.pm = fm + ((wgid % nig) % gsz); u.pn = (wgid % nig) / gsz; return true;
    }
    __device__ __forceinline__ void a_ready(const Unit&) const {}
    __device__ __forceinline__ void done(const Unit&) const {}
};

typedef float f32x2 __attribute__((ext_vector_type(2))); typedef __bf16 bf16x2v __attribute__((ext_vector_type(2)));
__device__ __forceinline__ unsigned cvt_pk_bf16(float lo, float hi) { f32x2 v = {lo, hi}; bf16x2v b = __builtin_convertvector(v, bf16x2v); return __builtin_bit_cast(unsigned, b); }
typedef unsigned u32x2 __attribute__((ext_vector_type(2)));
__device__ __forceinline__ float bf_lo(unsigned u) { return __uint_as_float(u << 16); }
__device__ __forceinline__ float bf_hi(unsigned u) { return __uint_as_float(u & 0xffff0000u); }
__device__ __forceinline__ float fast_sigmoid(float x) { return __builtin_amdgcn_rcpf(1.f + __builtin_amdgcn_exp2f(-1.4426950408889634f * x)); }
__device__ __forceinline__ float gelu_tanh(float x) { const float z = 1.5957691216057308f * x * (1.f + 0.044715f * x * x); return x * fast_sigmoid(z); }

struct EpiBf16Plain {
    static constexpr bool PERM = true, AFTER_DRAIN = false, PERMA = false;
    bf16_t* O; int ldc;
    __device__ __forceinline__ void operator()(const f32x4 (&acc)[2][2][4][2], const Unit& u, int wr, int wc, int fr, int fq) const {
        const int row0 = u.pm * BM + wr * 64 + fr, col0 = u.pn * BM + wc * 32 + 8 * fq;
#pragma unroll
        for (int ai = 0; ai < 2; ++ai)
#pragma unroll
            for (int m = 0; m < 4; ++m) { bf16_t* rowp = O + (size_t)(row0 + ai * HALF + m * 16) * ldc + col0;
#pragma unroll
                for (int bj = 0; bj < 2; ++bj) { const f32x4 v0 = acc[ai][bj][m][0], v1 = acc[ai][bj][m][1];
                    u32x4 w; w.x = cvt_pk_bf16(v0[0], v0[1]); w.y = cvt_pk_bf16(v0[2], v0[3]); w.z = cvt_pk_bf16(v1[0], v1[1]); w.w = cvt_pk_bf16(v1[2], v1[3]);
                    *(u32x4*)(rowp + bj * HALF) = w; } }
    }
};

struct EpiProj {
    static constexpr bool PERM = true, AFTER_DRAIN = false, PERMA = false;
    bf16_t* P; int ldp; const float* bias; bf16_t* VT; int seq; float c2;
    template <int KIND> __device__ __forceinline__ void run(const f32x4 (&acc)[2][2][4][2], const Unit& u, int wr, int wc, int fr, int fq) const {
        const int row0 = u.pm * BM + wr * 64 + fr, col0 = u.pn * BM + wc * 32 + 8 * fq;
        f32x4 bv[2][2];
#pragma unroll
        for (int bj = 0; bj < 2; ++bj)
#pragma unroll
            for (int n = 0; n < 2; ++n) bv[bj][n] = *(const f32x4*)(bias + col0 + bj * HALF + 4 * n);
#pragma unroll
        for (int ai = 0; ai < 2; ++ai)
#pragma unroll
            for (int m = 0; m < 4; ++m) { const int row = row0 + ai * HALF + m * 16; bf16_t* rowp = P + (size_t)row * ldp + col0;
#pragma unroll
                for (int bj = 0; bj < 2; ++bj) { f32x4 v0 = acc[ai][bj][m][0] + bv[bj][0], v1 = acc[ai][bj][m][1] + bv[bj][1];
                    if (KIND == 0) { v0 = v0 * c2; v1 = v1 * c2; }
                    if (KIND == 3) { v0 = (f32x4){gelu_tanh(v0[0]), gelu_tanh(v0[1]), gelu_tanh(v0[2]), gelu_tanh(v0[3])}; v1 = (f32x4){gelu_tanh(v1[0]), gelu_tanh(v1[1]), gelu_tanh(v1[2]), gelu_tanh(v1[3])}; }
                    if (KIND == 4) { v0 = (f32x4){fast_sigmoid(v0[0]), fast_sigmoid(v0[1]), fast_sigmoid(v0[2]), fast_sigmoid(v0[3])}; v1 = (f32x4){fast_sigmoid(v1[0]), fast_sigmoid(v1[1]), fast_sigmoid(v1[2]), fast_sigmoid(v1[3])}; }
                    u32x4 w; w.x = cvt_pk_bf16(v0[0], v0[1]); w.y = cvt_pk_bf16(v0[2], v0[3]); w.z = cvt_pk_bf16(v1[0], v1[1]); w.w = cvt_pk_bf16(v1[2], v1[3]);
                    *(u32x4*)(rowp + bj * HALF) = w;
                    if (KIND == 1 && bj == 1) {
                        const int b = row / seq, s = row - b * seq, dv0 = wc * 32 + 8 * fq;
                        bf16_t* vt = VT + ((size_t)(b * 2 + (dv0 >> 6)) * 64 + (dv0 & 63)) * seq + s;
                        vt[0 * (size_t)seq] = (bf16_t)(w.x & 0xffffu); vt[1 * (size_t)seq] = (bf16_t)(w.x >> 16);
                        vt[2 * (size_t)seq] = (bf16_t)(w.y & 0xffffu); vt[3 * (size_t)seq] = (bf16_t)(w.y >> 16);
                        vt[4 * (size_t)seq] = (bf16_t)(w.z & 0xffffu); vt[5 * (size_t)seq] = (bf16_t)(w.z >> 16);
                        vt[6 * (size_t)seq] = (bf16_t)(w.w & 0xffffu); vt[7 * (size_t)seq] = (bf16_t)(w.w >> 16);
                    } } }
    }
    __device__ __forceinline__ void operator()(const f32x4 (&acc)[2][2][4][2], const Unit& u, int wr, int wc, int fr, int fq) const {
        const int pn = u.pn;
        if (pn < 2) run<0>(acc, u, wr, wc, fr, fq);
        else if (pn == 2) run<1>(acc, u, wr, wc, fr, fq);
        else if (pn < 10) run<2>(acc, u, wr, wc, fr, fq);
        else if (pn < 14) run<3>(acc, u, wr, wc, fr, fq);
        else run<4>(acc, u, wr, wc, fr, fq);
    }
};

template <bool ADD> struct EpiGate {
    static constexpr bool PERM = true, AFTER_DRAIN = false, PERMA = false;
    const bf16_t* G; int ldg; const bf16_t* base; bf16_t* O; int ldc;
    __device__ __forceinline__ void operator()(const f32x4 (&acc)[2][2][4][2], const Unit& u, int wr, int wc, int fr, int fq) const {
        const int row0 = u.pm * BM + wr * 64 + fr, col0 = u.pn * BM + wc * 32 + 8 * fq;
#pragma unroll
        for (int ai = 0; ai < 2; ++ai)
#pragma unroll
            for (int m = 0; m < 4; ++m) { const size_t row = (size_t)(row0 + ai * HALF + m * 16);
#pragma unroll
                for (int bj = 0; bj < 2; ++bj) { const int col = col0 + bj * HALF;
                    const u32x4 gq = *(const u32x4*)(G + row * ldg + col);
                    f32x4 v0 = acc[ai][bj][m][0], v1 = acc[ai][bj][m][1];
                    v0 = v0 * (f32x4){bf_lo(gq.x), bf_hi(gq.x), bf_lo(gq.y), bf_hi(gq.y)}; v1 = v1 * (f32x4){bf_lo(gq.z), bf_hi(gq.z), bf_lo(gq.w), bf_hi(gq.w)};
                    if (ADD) { const u32x4 bq = *(const u32x4*)(base + row * ldc + col);
                        v0 = v0 + (f32x4){bf_lo(bq.x), bf_hi(bq.x), bf_lo(bq.y), bf_hi(bq.y)}; v1 = v1 + (f32x4){bf_lo(bq.z), bf_hi(bq.z), bf_lo(bq.w), bf_hi(bq.w)}; }
                    u32x4 w; w.x = cvt_pk_bf16(v0[0], v0[1]); w.y = cvt_pk_bf16(v0[2], v0[3]); w.z = cvt_pk_bf16(v1[0], v1[1]); w.w = cvt_pk_bf16(v1[2], v1[3]);
                    *(u32x4*)(O + row * ldc + col) = w; } }
    }
};

struct EpiResid {
    static constexpr bool PERM = false, AFTER_DRAIN = false, PERMA = false;
    const float* base; float* out; int ldc; const float* gvec; int gstride; int seq;
    __device__ __forceinline__ void operator()(const f32x4 (&acc)[2][2][4][2], const Unit& u, int wr, int wc, int fr, int fq) const {
        const int row0 = u.pm * BM + wr * 64 + fr, col0 = u.pn * BM + wc * 32 + 4 * fq;
        const float* gv = gvec + (size_t)((u.pm * BM) / seq) * gstride;
        f32x4 g4[2][2];
#pragma unroll
        for (int bj = 0; bj < 2; ++bj)
#pragma unroll
            for (int n = 0; n < 2; ++n) g4[bj][n] = *(const f32x4*)(gv + col0 + bj * HALF + n * 16);
#pragma unroll
        for (int ai = 0; ai < 2; ++ai)
#pragma unroll
            for (int m = 0; m < 4; ++m) { const size_t off = (size_t)(row0 + ai * HALF + m * 16) * ldc + col0;
#pragma unroll
                for (int bj = 0; bj < 2; ++bj)
#pragma unroll
                    for (int n = 0; n < 2; ++n) { const f32x4 bs = *(const f32x4*)(base + off + bj * HALF + n * 16);
                        *(f32x4*)(out + off + bj * HALF + n * 16) = bs + g4[bj][n] * acc[ai][bj][m][n]; }
                if (m & 1) asm volatile("" ::: "memory"); }
    }
};


__device__ __forceinline__ float dpp_shr1(float v) { return __builtin_bit_cast(float, __builtin_amdgcn_update_dpp(0, __builtin_bit_cast(int, v), 0x111, 0xf, 0xf, true)); }
__device__ __forceinline__ f32x4 dpp_shr1(f32x4 v) { return (f32x4){dpp_shr1(v[0]), dpp_shr1(v[1]), dpp_shr1(v[2]), dpp_shr1(v[3])}; }
struct EpiUpConv {
    static constexpr bool PERM = true, AFTER_DRAIN = false, PERMA = true;
    bf16_t* ACT; int dff; const float* cw; const float* cb; float* hpart; float* hx; PG8_LAS float* halo; int seq;
    __device__ __forceinline__ void operator()(const f32x4 (&acc)[2][2][4][2], const Unit& u, int wr, int wc, int fr, int fq) const {
        const int cl = wc * 32 + 8 * fq;
        const int j0 = u.pn * 128 + cl;
        const int tcol = u.pn * 256 + cl;
        const int ncol = 2 * dff;
        if (fr == 15) {
#pragma unroll
            for (int ai = 0; ai < 2; ++ai)
#pragma unroll
                for (int bj = 0; bj < 2; ++bj)
#pragma unroll
                    for (int n = 0; n < 2; ++n) { const int run = 2 * ai + wr; PG8_LAS float* hp = halo + (run * 2) * 256 + bj * 128 + cl + 4 * n;
                        *(PG8_LAS f32x4*)hp = acc[ai][bj][2][n]; *(PG8_LAS f32x4*)(hp + 256) = acc[ai][bj][3][n];
                        if (run == 3) { float* gx = hx + ((size_t)u.pm * 2) * ncol + tcol + bj * 128 + 4 * n; *(f32x4*)gx = acc[ai][bj][2][n]; *(f32x4*)(gx + ncol) = acc[ai][bj][3][n]; } }
        }
        asm volatile("s_waitcnt lgkmcnt(0)" ::: "memory"); __builtin_amdgcn_s_barrier(); asm volatile("" ::: "memory");
        const bool seq_start = ((u.pm * BM) % seq) == 0;
#pragma unroll
        for (int n = 0; n < 2; ++n) {
            f32x4 w0[2], w1[2], w2[2], bb[2];
#pragma unroll
            for (int bj = 0; bj < 2; ++bj) { const float* wp = cw + bj * dff + j0 + 4 * n;
                w0[bj] = *(const f32x4*)wp; w1[bj] = *(const f32x4*)(wp + ncol); w2[bj] = *(const f32x4*)(wp + 2 * ncol); bb[bj] = *(const f32x4*)(cb + bj * dff + j0 + 4 * n); }
#pragma unroll
            for (int ai = 0; ai < 2; ++ai) {
                const int run = 2 * ai + wr;
                f32x4 y[2][4];
#pragma unroll
                for (int bj = 0; bj < 2; ++bj) {
                    f32x4 h2 = {0.f, 0.f, 0.f, 0.f}, h3 = {0.f, 0.f, 0.f, 0.f};
                    if (run > 0 && fr == 0) { const PG8_LAS float* hp = halo + ((run - 1) * 2) * 256 + bj * 128 + cl + 4 * n; h2 = *(const PG8_LAS f32x4*)hp; h3 = *(const PG8_LAS f32x4*)(hp + 256); }
                    const f32x4 x0 = acc[ai][bj][0][n], x1 = acc[ai][bj][1][n], x2 = acc[ai][bj][2][n], x3 = acc[ai][bj][3][n];
                    const f32x4 p3 = dpp_shr1(x3) + h3, p2 = dpp_shr1(x2) + h2;
                    y[bj][0] = bb[bj] + w2[bj] * x0 + w1[bj] * p3 + w0[bj] * p2;
                    y[bj][1] = bb[bj] + w2[bj] * x1 + w1[bj] * x0 + w0[bj] * p3;
                    y[bj][2] = bb[bj] + w2[bj] * x2 + w1[bj] * x1 + w0[bj] * x0;
                    y[bj][3] = bb[bj] + w2[bj] * x3 + w1[bj] * x2 + w0[bj] * x1;
                }
                const size_t tok0 = (size_t)u.pm * BM + ai * HALF + wr * 64 + 4 * fr;
                if (run == 0 && fr == 0 && !seq_start) {
#pragma unroll
                    for (int bj = 0; bj < 2; ++bj) { float* gp = hpart + ((size_t)u.pm * 2) * ncol + tcol + bj * 128 + 4 * n; *(f32x4*)gp = y[bj][0]; *(f32x4*)(gp + ncol) = y[bj][1]; }
                }
#pragma unroll
                for (int m = 0; m < 4; ++m) { const f32x4 v = y[0][m], gt = y[1][m];
                    const f32x4 a = (f32x4){gt[0] * fast_sigmoid(gt[0]) * v[0], gt[1] * fast_sigmoid(gt[1]) * v[1], gt[2] * fast_sigmoid(gt[2]) * v[2], gt[3] * fast_sigmoid(gt[3]) * v[3]};
                    u32x2 wv; wv.x = cvt_pk_bf16(a[0], a[1]); wv.y = cvt_pk_bf16(a[2], a[3]);
                    *(u32x2*)(ACT + (tok0 + m) * dff + j0 + 4 * n) = wv; }
            }
        }
    }
};
template <class Epi, class Sched, bool ALIGN_EPI = false, bool SP2 = false>
__device__ __forceinline__ void gemm_phase(PG8_LAS unsigned char* lds, const Gemm g, const Sched& S, const Epi& E) {
    const int tid = threadIdx.x, wid = __builtin_amdgcn_readfirstlane(tid >> 6), lane = tid & 63, wr = wid >> 2, wc = wid & 3, fr = lane & 15, fq = lane >> 4;
    const int K = g.K, nt = K / BK;
    unsigned voffA[2], voffB[2];
#pragma unroll
    for (int i = 0; i < 2; ++i) { int R, C; stage_rc(tid * 16 + i * 8192, R, C); const int Rb = Epi::PERM ? ((R & ~31) + perm32(R & 31)) : R;
        const int Ra = Epi::PERMA ? ((R & 64) | ((R & 15) << 2) | ((R >> 4) & 3)) : R;
        voffA[i] = (unsigned)(Ra * g.lda + C) * 2u; voffB[i] = (unsigned)(Rb * g.ldb + C) * 2u; }
    const size_t kstep = (size_t)(BK * 2);
    const size_t hstepA = (size_t)HALF * g.lda * 2, hstepB = (size_t)HALF * g.ldb * 2;
    const size_t tstepA = 2 * hstepA, tstepB = 2 * hstepB;
    const unsigned ldsw = (unsigned)wid * 1024u;
    const int aoff = lds_byte(wr * 64 + fr, fq * 8), boff = lds_byte(wc * 32 + fr, fq * 8);
#define PG8_SA(b, h) (((b) * 2 + (h)) * HTB)
#define PG8_SB(b, h) ((4 + (b) * 2 + (h)) * HTB)
#define PG8_STAGE(bufoff, gbase, voff) do { _Pragma("unroll") for (int _i = 0; _i < 2; ++_i) \
        __builtin_amdgcn_global_load_lds((const unsigned*)((const char*)(gbase) + (voff)[_i]), (PG8_LAS unsigned*)(lds + (bufoff) + ldsw + _i * 8192), 16, 0, 0); } while (0)
#define PG8_LDA(dst, b, h) do { _Pragma("unroll") for (int m = 0; m < 4; ++m) _Pragma("unroll") for (int k = 0; k < 2; ++k) dst[m][k] = *(const PG8_LAS bf16x8*)(lds + PG8_SA(b, h) + aoff + m * 2048 + k * 1024); } while (0)
#define PG8_LDB(dst, b, h) do { _Pragma("unroll") for (int n = 0; n < 2; ++n) _Pragma("unroll") for (int k = 0; k < 2; ++k) dst[n][k] = *(const PG8_LAS bf16x8*)(lds + PG8_SB(b, h) + boff + n * 2048 + k * 1024); } while (0)
#define PG8_MMA(ai, bj, At, Bt) do { __builtin_amdgcn_s_setprio(1); _Pragma("unroll") for (int m = 0; m < 4; ++m) _Pragma("unroll") for (int n = 0; n < 2; ++n) _Pragma("unroll") for (int k = 0; k < 2; ++k) \
        acc[ai][bj][m][n] = __builtin_amdgcn_mfma_f32_16x16x32_bf16(Bt[n][k], At[m][k], acc[ai][bj][m][n], 0, 0, 0); __builtin_amdgcn_s_setprio(0); } while (0)
#define PG8_WAIT_V(n) asm volatile("s_waitcnt vmcnt(" #n ")" ::: "memory")
#define PG8_WAIT_L(n) asm volatile("s_waitcnt lgkmcnt(" #n ")" ::: "memory")
#define PG8_BAR __builtin_amdgcn_s_barrier()
#define PG8_SCHED __builtin_amdgcn_sched_barrier(0)
    Unit cur, nxt; int ui = 0;
    if (!S.next(0, cur)) return;
    f32x4 acc[2][2][4][2];
#pragma unroll
    for (int a = 0; a < 2; ++a)
#pragma unroll
        for (int b = 0; b < 2; ++b)
#pragma unroll
            for (int m = 0; m < 4; ++m)
#pragma unroll
                for (int n = 0; n < 2; ++n) acc[a][b][m][n] = (f32x4){0.f, 0.f, 0.f, 0.f};
    bf16x8 At[4][2], B0[2][2], B1[2][2];
    const char* cA = (const char*)g.A + (size_t)cur.pm * tstepA; const char* cB = (const char*)g.Bt + (size_t)cur.pn * tstepB;
    S.a_ready(cur);
    if constexpr (SP2) {
        PG8_STAGE(PG8_SB(0, 0), cB, voffB); PG8_STAGE(PG8_SB(0, 1), cB + hstepB, voffB); PG8_STAGE(PG8_SA(0, 0), cA, voffA); PG8_STAGE(PG8_SA(0, 1), cA + hstepA, voffA);
        if (wr == 1) PG8_BAR;
        PG8_WAIT_V(2); PG8_BAR;
        PG8_STAGE(PG8_SB(1, 0), cB + kstep, voffB); PG8_STAGE(PG8_SA(1, 0), cA + kstep, voffA); PG8_STAGE(PG8_SB(1, 1), cB + hstepB + kstep, voffB);
        PG8_WAIT_V(6); PG8_BAR;
    } else {
        PG8_STAGE(PG8_SB(0, 0), cB, voffB); PG8_STAGE(PG8_SA(0, 0), cA, voffA); PG8_STAGE(PG8_SB(0, 1), cB + hstepB, voffB); PG8_STAGE(PG8_SA(0, 1), cA + hstepA, voffA);
        if (wr == 1) PG8_BAR;
        PG8_WAIT_V(4); PG8_BAR;
        PG8_STAGE(PG8_SB(1, 0), cB + kstep, voffB); PG8_STAGE(PG8_SA(1, 0), cA + kstep, voffA); PG8_STAGE(PG8_SB(1, 1), cB + hstepB + kstep, voffB);
        PG8_WAIT_V(6); PG8_BAR;
    }
    for (;;) {
        const bool has_next = S.next(ui + 1, nxt);
        const char* nA = has_next ? (const char*)g.A + (size_t)nxt.pm * tstepA : cA; const char* nB = has_next ? (const char*)g.Bt + (size_t)nxt.pn * tstepB : cB;
        for (int t = 0; t < nt; t += 2) {
            const bool last = (t == nt - 2);
            const char* a1 = cA + (size_t)(t + 1) * kstep;
            const char* a2 = last ? nA : cA + (size_t)(t + 2) * kstep; const char* b2 = last ? nB : cB + (size_t)(t + 2) * kstep;
            const char* a3 = a2 + kstep; const char* b3 = b2 + kstep;
            if (last && has_next) S.a_ready(nxt);
            if constexpr (SP2) {
            PG8_LDB(B0, 0, 0); PG8_LDB(B1, 0, 1); PG8_SCHED; PG8_LDA(At, 0, 0); PG8_STAGE(PG8_SA(1, 1), a1 + hstepA, voffA);
            PG8_WAIT_V(8); PG8_WAIT_L(0); PG8_BAR; PG8_MMA(0, 0, At, B0); PG8_MMA(0, 1, At, B1); PG8_BAR; PG8_SCHED;
            PG8_LDA(At, 0, 1); PG8_STAGE(PG8_SB(0, 0), b2, voffB); PG8_STAGE(PG8_SB(0, 1), b2 + hstepB, voffB); PG8_STAGE(PG8_SA(0, 0), a2, voffA);
            PG8_WAIT_V(8); PG8_WAIT_L(0); PG8_BAR; PG8_MMA(1, 0, At, B0); PG8_MMA(1, 1, At, B1); PG8_BAR; PG8_SCHED;
            PG8_LDB(B0, 1, 0); PG8_LDB(B1, 1, 1); PG8_SCHED; PG8_LDA(At, 1, 0); PG8_STAGE(PG8_SA(0, 1), a2 + hstepA, voffA);
            PG8_WAIT_V(8); PG8_WAIT_L(0); PG8_BAR; PG8_MMA(0, 0, At, B0); PG8_MMA(0, 1, At, B1); PG8_BAR; PG8_SCHED;
            PG8_LDA(At, 1, 1); PG8_STAGE(PG8_SB(1, 0), b3, voffB); PG8_STAGE(PG8_SB(1, 1), b3 + hstepB, voffB); PG8_STAGE(PG8_SA(1, 0), a3, voffA);
            PG8_WAIT_V(8); PG8_WAIT_L(0); PG8_BAR; PG8_MMA(1, 0, At, B0); PG8_MMA(1, 1, At, B1); PG8_BAR; PG8_SCHED;
            } else {
            PG8_LDB(B0, 0, 0); PG8_SCHED; PG8_LDA(At, 0, 0); PG8_STAGE(PG8_SA(1, 1), a1 + hstepA, voffA);
            PG8_WAIT_L(8); PG8_BAR; PG8_WAIT_L(0); PG8_MMA(0, 0, At, B0); PG8_BAR; PG8_SCHED;
            PG8_LDB(B1, 0, 1); PG8_STAGE(PG8_SB(0, 0), b2, voffB);
            PG8_BAR; PG8_WAIT_L(0); PG8_MMA(0, 1, At, B1); PG8_BAR;
            PG8_LDA(At, 0, 1); PG8_STAGE(PG8_SA(0, 0), a2, voffA);
            PG8_BAR; PG8_WAIT_L(0); PG8_MMA(1, 0, At, B0); PG8_BAR; PG8_SCHED;
            PG8_STAGE(PG8_SB(0, 1), b2 + hstepB, voffB);
            PG8_WAIT_V(6); PG8_BAR; PG8_MMA(1, 1, At, B1); PG8_BAR;
            PG8_LDB(B0, 1, 0); PG8_SCHED; PG8_LDA(At, 1, 0); PG8_STAGE(PG8_SA(0, 1), a2 + hstepA, voffA);
            PG8_WAIT_L(8); PG8_BAR; PG8_WAIT_L(0); PG8_MMA(0, 0, At, B0); PG8_BAR; PG8_SCHED;
            PG8_LDB(B1, 1, 1); PG8_STAGE(PG8_SB(1, 0), b3, voffB);
            PG8_BAR; PG8_WAIT_L(0); PG8_MMA(0, 1, At, B1); PG8_BAR;
            PG8_LDA(At, 1, 1); PG8_STAGE(PG8_SA(1, 0), a3, voffA);
            PG8_BAR; PG8_WAIT_L(0); PG8_MMA(1, 0, At, B0); PG8_BAR; PG8_SCHED;
            PG8_STAGE(PG8_SB(1, 1), b3 + hstepB, voffB);
            PG8_WAIT_V(6); PG8_BAR; PG8_MMA(1, 1, At, B1); PG8_BAR;
            }
        }
        if constexpr (ALIGN_EPI) { if (wr == 0) PG8_BAR; }
        if constexpr (!Epi::AFTER_DRAIN) { E(acc, cur, wr, wc, fr, fq); S.done(cur); }
        if (!has_next) break;
#pragma unroll
        for (int a = 0; a < 2; ++a)
#pragma unroll
            for (int b = 0; b < 2; ++b)
#pragma unroll
                for (int m = 0; m < 4; ++m)
#pragma unroll
                    for (int n = 0; n < 2; ++n) acc[a][b][m][n] = (f32x4){0.f, 0.f, 0.f, 0.f};
        cur = nxt; cA = nA; cB = nB; ++ui;
        if constexpr (ALIGN_EPI) { if (wr == 1) PG8_BAR; }
    }
    PG8_WAIT_V(0);
    if constexpr (!ALIGN_EPI) { if (wr == 0) PG8_BAR; }
    PG8_BAR;
    if constexpr (Epi::AFTER_DRAIN) { E.fused(acc, cur, wr, wc, fr, fq, lds, wid, lane); S.done(cur); }
#undef PG8_SA
#undef PG8_SB
#undef PG8_STAGE
#undef PG8_LDA
#undef PG8_LDB
#undef PG8_MMA
#undef PG8_WAIT_V
#undef PG8_WAIT_L
#undef PG8_BAR
#undef PG8_SCHED
}
}

#define GAS __attribute__((address_space(1)))
#define LAS __attribute__((address_space(3)))
typedef unsigned short bf16;
typedef unsigned v4u __attribute__((ext_vector_type(4)));
typedef float f32x4 __attribute__((ext_vector_type(4)));
typedef short bf16x8 __attribute__((ext_vector_type(8)));
typedef GAS unsigned gu32;
typedef GAS unsigned long long gu64;
#define RLX_AGENT __ATOMIC_RELAXED, __HIP_MEMORY_SCOPE_AGENT
#define LDS_WAIT() asm volatile("s_waitcnt lgkmcnt(0)" ::: "memory")
#define VM_WAIT() asm volatile("s_waitcnt vmcnt(0)" ::: "memory")
__device__ __forceinline__ unsigned long long rt() { return __builtin_amdgcn_s_memrealtime(); }
__device__ __forceinline__ unsigned f2bf(float f) { unsigned u = __builtin_bit_cast(unsigned, f); return (u + 0x7fffu + ((u >> 16) & 1u)) >> 16; }
__device__ __forceinline__ unsigned pk2(float lo, float hi) { return f2bf(lo) | (f2bf(hi) << 16); }

#define XB_TMO      128
#define XB_XCNT(j)  (256  + 64 * (j))
#define XB_XSUB(j)  (1280 + 64 * (j))
#define XB_XGEN(j)  (2304 + 64 * (j))
#define XB_TOP      3328
#define XB_TOPGEN   3392
#define XCD_BAR_WORDS 3456
#define XB_SPIN_CAP (1u << 18)

__device__ __forceinline__ unsigned xb_ld(unsigned* p)              { return __hip_atomic_load(p, __ATOMIC_RELAXED, __HIP_MEMORY_SCOPE_AGENT); }
__device__ __forceinline__ unsigned xb_add(unsigned* p, unsigned v) { return __hip_atomic_fetch_add(p, v, __ATOMIC_RELAXED, __HIP_MEMORY_SCOPE_AGENT); }
__device__ __forceinline__ unsigned xb_xcc_id() { return (unsigned)__builtin_amdgcn_s_getreg((3 << 11) | 20) & 0xFu; }
#define XB_SPIN(cond, bar) do { unsigned _sp = 0; while (cond) { __builtin_amdgcn_s_sleep(1); \
    if ((++_sp & 255u) == 0u) { if (xb_ld(&(bar)[XB_TMO])) break; if (_sp > XB_SPIN_CAP) { atomicAdd(&(bar)[XB_TMO], 1u); break; } } } } while (0)

struct XcdBarrier {
    unsigned* bar; unsigned x;
    volatile LAS unsigned* st;
};

__device__ __forceinline__ XcdBarrier xcd_barrier_post(unsigned* bar, volatile LAS unsigned* st) {
    XcdBarrier b; b.bar = bar; b.x = xb_xcc_id(); b.st = st;
    if (threadIdx.x == 0) (void)xb_add(&bar[XB_XCNT(b.x)], 1u);
    return b;
}
__device__ __forceinline__ void xcd_barrier_complete(unsigned* bar, unsigned x, unsigned& nloc, unsigned& nx) {
    const unsigned G = gridDim.x * gridDim.y * gridDim.z;
    unsigned sum, cnt, mine, sp = 0u;
    for (;;) {
        sum = 0u; cnt = 0u; mine = 0u;
#pragma unroll
        for (unsigned j = 0; j < 16; ++j) { const unsigned c = xb_ld(&bar[XB_XCNT(j)]); sum += c; cnt += (c > 0u) ? 1u : 0u; mine = (j == x) ? c : mine; }
        if (sum == G) break;
        __builtin_amdgcn_s_sleep(1);
        if ((++sp & 255u) == 0u) { if (xb_ld(&bar[XB_TMO])) break; if (sp > XB_SPIN_CAP) { atomicAdd(&bar[XB_TMO], 1u); break; } }
    }
    nloc = mine > 0u ? mine : 1u; nx = cnt > 0u ? cnt : 1u;
}

__device__ __forceinline__ void xcd_barrier(const XcdBarrier& b) {
    asm volatile("s_waitcnt vmcnt(0)" ::: "memory");
    __syncthreads();
    if (threadIdx.x == 0) {
        unsigned* bar = b.bar;
        __builtin_amdgcn_s_waitcnt(0);
        unsigned nloc = b.st[0], nx = b.st[1];
        if (nloc == 0u) { xcd_barrier_complete(bar, b.x, nloc, nx); b.st[0] = nloc; b.st[1] = nx; }
        const unsigned old = xb_add(&bar[XB_XSUB(b.x)], 1u);
        const unsigned gen = old / nloc;
        if (old + 1u == (gen + 1u) * nloc) {
            __builtin_amdgcn_fence(__ATOMIC_RELEASE, "agent");
            asm volatile("s_waitcnt vmcnt(0)" ::: "memory");
            const unsigned og = xb_add(&bar[XB_TOP], 1u);
            const unsigned tg = og / nx;
            if (og + 1u == (tg + 1u) * nx) xb_add(&bar[XB_TOPGEN], 1u);
            else XB_SPIN(xb_ld(&bar[XB_TOPGEN]) == tg, bar);
            __builtin_amdgcn_fence(__ATOMIC_ACQUIRE, "agent");
            xb_add(&bar[XB_XGEN(b.x)], 1u);
            asm volatile("s_waitcnt vmcnt(0)" ::: "memory");
        } else {
            XB_SPIN(xb_ld(&bar[XB_XGEN(b.x)]) == gen, bar);
            __builtin_amdgcn_fence(__ATOMIC_ACQUIRE, "agent");
            asm volatile("s_waitcnt vmcnt(0)" ::: "memory");
        }
    }
    __syncthreads();
}

constexpr int NWAVES = 8;
constexpr int BATCH = 32, SEQ = 2048, D = 1024, M = BATCH * SEQ;
constexpr int NH = 8, HD = 64, NKV = 2, IH = 8, IDIM = 64, NSEL = 256;
constexpr int DFF = 2816, NIN = 5448, NMOD = 6 * D;
constexpr int LDP = 5632;
constexpr int PC_Q = 0, PC_K = 512, PC_V = 640, PC_QI = 768, PC_KI = 1280, PC_WI = 1344, PC_XR = 1536, PC_YR = 2560, PC_GA = 3584, PC_GB = 4608;
constexpr int LDAR = 1536;
constexpr int HFF = DFF / 2;
constexpr float EPS = 1e-6f, LOG2E = 1.4426950408889634f, QSCALE = 0.125f * 1.4426950408889634f;

constexpr size_t MiB = 1u << 20;
constexpr size_t WS_CTL = 0, CTL_ZERO_BYTES = 1 * MiB;
constexpr size_t WS_MOD = 1 * MiB;
constexpr size_t WS_BIASP = 1 * MiB + 832 * 1024;
constexpr size_t WS_WIN = 2 * MiB, WS_WUP = 13 * MiB, WS_WDN = 24 * MiB, WS_WOA = 30 * MiB, WS_WOR = 31 * MiB, WS_WOUT = 33 * MiB, WS_WRG = 35 * MiB, WS_WIG = 35 * MiB + 512 * 1024;
constexpr size_t WS_VT = 40 * MiB;
constexpr size_t WS_A = 64 * MiB;
constexpr size_t WS_ACT = WS_A + 352 * MiB;
constexpr size_t WS_B = 768 * MiB;
constexpr size_t WS_C = 896 * MiB;
constexpr size_t WS_END = 1024 * MiB;
static_assert(WS_MOD + (size_t)BATCH * NMOD * 4 <= WS_BIASP && WS_BIASP + LDP * 4 <= WS_WIN, "ws map");
static_assert(WS_WIN + (size_t)LDP * D * 2 <= WS_WUP && WS_WUP + (size_t)LDP * D * 2 <= WS_WDN && WS_WDN + (size_t)D * DFF * 2 <= WS_WOA, "ws map");
static_assert(WS_A + (size_t)M * LDP * 2 <= WS_B && WS_ACT + (size_t)M * DFF * 2 <= WS_B && WS_B + (size_t)M * D * 2 <= WS_C && WS_C + (size_t)M * D * 2 <= WS_END, "ws map");
constexpr int CW_TMO = 0, CW_CODE = 1, CW_BAR = 4096;

constexpr int RING_OFF = 0, RING_BYTES = 131072;
constexpr int LDSCTL_OFF = RING_BYTES, MISC_OFF = LDSCTL_OFF + 320;
constexpr int LDS_BYTES = 147456;


typedef unsigned u32x2 __attribute__((ext_vector_type(2)));
typedef float f32x16 __attribute__((ext_vector_type(16)));
struct Frame {
    LAS unsigned char* lds;
    volatile LAS unsigned* MISC;
    gu32* ctl;
    int tid, lane, wave;
    int vcu, G;
    const float *x, *c, *w_ada, *b_ada, *g_mix, *w_in, *b_in, *rel_bias, *conv_rnn_w, *conv_rnn_b, *w_rg, *b_rg, *w_ig, *b_ig, *lru_lambda,
                *w_o_attn, *w_o_rnn, *w_out, *g_ffn, *w_up, *conv_ffn_w, *conv_ffn_b, *w_down, *g_final;
    float* out;
    float *mod, *biasp, *hpart, *hx;
    bf16 *Win_t, *Wup_t, *Wdn_t, *Woa_t, *Wor_t, *Wout_t, *Wrg_t, *Wig_t;
    bf16 *VT, *P, *UPH, *ACT, *XN, *T1, *MG, *AR;
};
__device__ __forceinline__ float bf2f_lo(unsigned u) { return __uint_as_float(u << 16); }
__device__ __forceinline__ float bf2f_hi(unsigned u) { return __uint_as_float(u & 0xffff0000u); }
__device__ __forceinline__ float bf1(bf16 v) { return __uint_as_float(((unsigned)v) << 16); }
typedef float f32x2_t __attribute__((ext_vector_type(2))); typedef __bf16 bf16x2_t __attribute__((ext_vector_type(2)));
__device__ __forceinline__ unsigned cvtpk(float lo, float hi) { f32x2_t v = {lo, hi}; bf16x2_t b = __builtin_convertvector(v, bf16x2_t); return __builtin_bit_cast(unsigned, b); }
__device__ __forceinline__ float wave_sum(float v) {
#pragma unroll
    for (int o = 1; o < 64; o <<= 1) v += __shfl_xor(v, o);
    return v;
}
__device__ __forceinline__ float sigmoidf_(float x) { return __builtin_amdgcn_rcpf(1.f + __builtin_amdgcn_exp2f(-LOG2E * x)); }

__device__ __forceinline__ void tr_item(const float* W, int ldw, int k0, int c0, int nvalid, bf16* WT, int ldt, int r0, LAS float* scr, int lane) {
#pragma unroll 8
    for (int i = 0; i < 32; ++i) { const int kk = 2 * i + (lane >> 5), n = lane & 31; scr[kk * 33 + n] = (n < nvalid) ? W[(size_t)(k0 + kk) * ldw + c0 + n] : 0.f; }
    LDS_WAIT(); asm volatile("" ::: "memory");
    const int c = lane & 7;
#pragma unroll
    for (int j = 0; j < 4; ++j) { const int n = (lane >> 3) + 8 * j; const LAS float* s = scr + (8 * c) * 33 + n;
        v4u o; o.x = pk2(s[0 * 33], s[1 * 33]); o.y = pk2(s[2 * 33], s[3 * 33]); o.z = pk2(s[4 * 33], s[5 * 33]); o.w = pk2(s[6 * 33], s[7 * 33]);
        *(GAS v4u*)(WT + (size_t)(r0 + n) * ldt + k0 + 8 * c) = o; }
    LDS_WAIT(); asm volatile("" ::: "memory");
}
__device__ __forceinline__ int proj_src_col(int d) { return d < 1352 ? d : (d >= 1536 ? d - 184 : -1); }

__device__ __forceinline__ void p0_prologue(Frame& F) {
    LAS float* scr = (LAS float*)(F.lds + RING_OFF + F.wave * 16384);
    const int gw = F.vcu * NWAVES + F.wave, NGW = F.G * NWAVES;
    constexpr int I_IN = 16 * 176, I_UP = 16 * 176, I_DN = 44 * 32, I_OA = 8 * 32, I_OR = 16 * 32, I_OUT = 16 * 32, I_RG = 64, I_IG = 64;
    constexpr int NITEMS = I_IN + I_UP + I_DN + I_OA + I_OR + I_OUT + I_RG + I_IG;
    for (int it = gw; it < NITEMS; it += NGW) {
        int r = it;
        if (r < I_IN) { const int kb = r / 176, d0 = 32 * (r % 176); int c0 = 0, nv = 32;
            if (d0 < 1344) c0 = d0; else if (d0 == 1344) { c0 = 1344; nv = 8; } else if (d0 < 1536) { c0 = 0; nv = 0; } else c0 = d0 - 184;
            tr_item(F.w_in, NIN, 64 * kb, c0, nv, F.Win_t, D, d0, scr, F.lane); continue; } r -= I_IN;
        if (r < I_UP) { const int kb = r / 176, d0 = 32 * (r % 176); const int tl = d0 >> 8, wi = d0 & 255;
            const int c0 = (wi < 128) ? 128 * tl + wi : DFF + 128 * tl + (wi - 128);
            tr_item(F.w_up, 2 * DFF, 64 * kb, c0, 32, F.Wup_t, D, d0, scr, F.lane); continue; } r -= I_UP;
        if (r < I_DN) { const int kb = r / 32, nb = r % 32; tr_item(F.w_down, D, 64 * kb, 32 * nb, 32, F.Wdn_t, DFF, 32 * nb, scr, F.lane); continue; } r -= I_DN;
        if (r < I_OA) { const int kb = r / 32, nb = r % 32; tr_item(F.w_o_attn, D, 64 * kb, 32 * nb, 32, F.Woa_t, 512, 32 * nb, scr, F.lane); continue; } r -= I_OA;
        if (r < I_OR) { const int kb = r / 32, nb = r % 32; tr_item(F.w_o_rnn, D, 64 * kb, 32 * nb, 32, F.Wor_t, D, 32 * nb, scr, F.lane); continue; } r -= I_OR;
        if (r < I_OUT) { const int kb = r / 32, nb = r % 32; tr_item(F.w_out, D, 64 * kb, 32 * nb, 32, F.Wout_t, D, 32 * nb, scr, F.lane); continue; } r -= I_OUT;
        if (r < I_RG) { const int blk = r / 8, rr = r % 8, kb = rr / 4, nb = rr % 4; tr_item(F.w_rg + blk * 16384, 128, 64 * kb, 32 * nb, 32, F.Wrg_t + blk * 16384, 128, 32 * nb, scr, F.lane); continue; } r -= I_RG;
        { const int blk = r / 8, rr = r % 8, kb = rr / 4, nb = rr % 4; tr_item(F.w_ig + blk * 16384, 128, 64 * kb, 32 * nb, 32, F.Wig_t + blk * 16384, 128, 32 * nb, scr, F.lane); }
    }
    for (int d = F.vcu * (NWAVES * 64) + F.tid; d < LDP; d += F.G * NWAVES * 64) { const int s = proj_src_col(d); F.biasp[d] = (s >= 0) ? F.b_in[s] : 0.f; }
    __syncthreads();
    for (int item = F.vcu; item < NMOD / 64; item += F.G) {
        LAS float* cs = (LAS float*)(F.lds + RING_OFF);
        for (int i = F.tid; i < BATCH * D; i += NWAVES * 64) { const float v = F.c[i]; cs[i] = v * sigmoidf_(v); }
        __syncthreads();
        const int col = item * 64 + F.lane, kbase = F.wave * 128;
        float acc[BATCH];
#pragma unroll
        for (int b = 0; b < BATCH; ++b) acc[b] = 0.f;
        for (int k4 = 0; k4 < 32; ++k4) {
            const int k = kbase + 4 * k4;
            const float w0 = F.w_ada[(size_t)(k + 0) * NMOD + col], w1 = F.w_ada[(size_t)(k + 1) * NMOD + col], w2 = F.w_ada[(size_t)(k + 2) * NMOD + col], w3 = F.w_ada[(size_t)(k + 3) * NMOD + col];
#pragma unroll
            for (int b = 0; b < BATCH; ++b) { const f32x4 c4 = *(const LAS f32x4*)(cs + b * D + k); acc[b] += (c4.x * w0 + c4.y * w1) + (c4.z * w2 + c4.w * w3); }
        }
        __syncthreads();
        LAS float* red = (LAS float*)(F.lds + RING_OFF);
#pragma unroll
        for (int b = 0; b < BATCH; ++b) red[(F.wave * BATCH + b) * 64 + F.lane] = acc[b];
        __syncthreads();
        for (int o = F.tid; o < BATCH * 64; o += NWAVES * 64) { const int b = o >> 6, l = o & 63; float s = F.b_ada[item * 64 + l];
#pragma unroll
            for (int w = 0; w < NWAVES; ++w) s += red[(w * BATCH + b) * 64 + l];
            F.mod[(size_t)b * NMOD + item * 64 + l] = s; }
        __syncthreads();
    }
}

__device__ __forceinline__ void p_norm_mod(Frame& F, const float* src, bf16* dst, const float* g, int sh_off, int sc_off) {
    const int gw = F.vcu * NWAVES + F.wave, NGW = F.G * NWAVES;
    for (int rb = gw; rb < M / 32; rb += NGW) {
        const int b = rb / (SEQ / 32);
        const float* mb = F.mod + (size_t)b * NMOD;
        f32x4 gm[4], sh[4];
#pragma unroll
        for (int j = 0; j < 4; ++j) { const int col = 4 * F.lane + 256 * j; const f32x4 gg = *(const f32x4*)(g + col), sc = *(const f32x4*)(mb + sc_off + col); sh[j] = *(const f32x4*)(mb + sh_off + col); gm[j] = gg * (sc + 1.0f); }
        for (int r = 0; r < 32; ++r) {
            const size_t row = (size_t)rb * 32 + r;
            const GAS f32x4* xr = (const GAS f32x4*)(src + row * D) + F.lane;
            f32x4 v[4]; float s = 0.f;
#pragma unroll
            for (int j = 0; j < 4; ++j) { v[j] = xr[64 * j]; s += (v[j].x * v[j].x + v[j].y * v[j].y) + (v[j].z * v[j].z + v[j].w * v[j].w); }
            const float rstd = 1.0f / sqrtf(wave_sum(s) * (1.f / D) + EPS);
            GAS u32x2* o8 = (GAS u32x2*)(dst + row * D) + F.lane;
#pragma unroll
            for (int j = 0; j < 4; ++j) { const f32x4 o = v[j] * rstd * gm[j] + sh[j]; u32x2 w; w.x = cvtpk(o.x, o.y); w.y = cvtpk(o.z, o.w); o8[64 * j] = w; }
        }
    }
}
__device__ __forceinline__ void p_norm_final(Frame& F) {
    const int gw = F.vcu * NWAVES + F.wave, NGW = F.G * NWAVES;
    f32x4 gm[4];
#pragma unroll
    for (int j = 0; j < 4; ++j) gm[j] = *(const f32x4*)(F.g_final + 4 * F.lane + 256 * j);
    for (int rb = gw; rb < M / 32; rb += NGW)
        for (int r = 0; r < 32; ++r) {
            const size_t row = (size_t)rb * 32 + r;
            GAS f32x4* xr = (GAS f32x4*)(F.out + row * D) + F.lane;
            f32x4 v[4]; float s = 0.f;
#pragma unroll
            for (int j = 0; j < 4; ++j) { v[j] = xr[64 * j]; s += (v[j].x * v[j].x + v[j].y * v[j].y) + (v[j].z * v[j].z + v[j].w * v[j].w); }
            const float rstd = 1.0f / sqrtf(wave_sum(s) * (1.f / D) + EPS);
#pragma unroll
            for (int j = 0; j < 4; ++j) xr[64 * j] = v[j] * rstd * gm[j];
        }
}

__device__ __forceinline__ void p_ffn_fix(Frame& F) {
    const int T = F.vcu * (NWAVES * 64) + F.tid, NT = F.G * NWAVES * 64;
    for (int it = T; it < (M / 256) * 2 * DFF; it += NT) {
        const int j = it % DFF, pt = it / DFF, tok = pt & 1, pm = pt >> 1;
        if ((pm * 256) % SEQ == 0) continue;
        const int tcv = (j >> 7) * 256 + (j & 127), tcg = tcv + 128;
        const float* hp = F.hpart + ((size_t)pm * 2 + tok) * (2 * DFF);
        const float* hxp = F.hx + ((size_t)(pm - 1) * 2) * (2 * DFF);
        float v = hp[tcv], gt = hp[tcg];
        const float w0v = F.conv_ffn_w[j], w1v = F.conv_ffn_w[2 * DFF + j], w0g = F.conv_ffn_w[DFF + j], w1g = F.conv_ffn_w[2 * DFF + DFF + j];
        const float x2v = hxp[tcv], x3v = hxp[2 * DFF + tcv], x2g = hxp[tcg], x3g = hxp[2 * DFF + tcg];
        if (tok == 0) { v += w1v * x3v + w0v * x2v; gt += w1g * x3g + w0g * x2g; } else { v += w0v * x3v; gt += w0g * x3g; }
        F.ACT[((size_t)pm * 256 + tok) * DFF + j] = (bf16)f2bf(gt * sigmoidf_(gt) * v);
    }
}

__constant__ unsigned char T5_BUCKET[128] = {
    0, 1, 2, 3, 4, 5, 6, 7, 8, 9, 10, 11, 12, 13, 14, 15, 16, 16, 16, 17, 17, 18, 18, 18, 19, 19, 19, 20, 20, 20, 20, 21, 21, 21, 21, 22, 22, 22, 22, 22,
    23, 23, 23, 23, 23, 23, 24, 24, 24, 24, 24, 24, 25, 25, 25, 25, 25, 25, 25, 26, 26, 26, 26, 26, 26, 26, 26, 27, 27, 27, 27, 27, 27, 27, 27, 27, 27,
    28, 28, 28, 28, 28, 28, 28, 28, 28, 28, 29, 29, 29, 29, 29, 29, 29, 29, 29, 29, 29, 29, 30, 30, 30, 30, 30, 30, 30, 30, 30, 30, 30, 30, 30, 30,
    31, 31, 31, 31, 31, 31, 31, 31, 31, 31, 31, 31, 31, 31, 31};
constexpr int ATT_MASK_OFF = 0;
constexpr int ATT_TBL_OFF = 16384;
constexpr int ATT_KI_OFF = 20480, ATT_KI_STRIDE = 144, ATT_KI_BUF = 64 * ATT_KI_STRIDE;
constexpr int ATT_K_OFF = 40960, ATT_K_STRIDE = 272, ATT_K_BUF = 64 * ATT_K_STRIDE;
constexpr int ATT_VT_OFF = ATT_K_OFF + 2 * ATT_K_BUF, ATT_VT_STRIDE = 136, ATT_VT_BUF = 128 * ATT_VT_STRIDE;
static_assert(ATT_VT_OFF + 2 * ATT_VT_BUF <= RING_BYTES && ATT_KI_OFF + 2 * ATT_KI_BUF <= ATT_K_OFF, "attention LDS map");
__device__ __forceinline__ unsigned ord_key(float s) { const unsigned u = __float_as_uint(s); return (u & 0x80000000u) ? ~u : (u | 0x80000000u); }
#define KEEP4(dep, a) asm volatile("" : "+v"(dep) : "v"((a)[0]), "v"((a)[1]), "v"((a)[2]), "v"((a)[3]))

__device__ __forceinline__ void attn_unit(Frame& F, int b, int qb) {
    const int tid = F.tid, w = F.wave;
    LAS unsigned char* L = F.lds + RING_OFF;
    LAS unsigned* maskL = (LAS unsigned*)(L + ATT_MASK_OFF);
    const LAS float* tbl = (const LAS float*)(L + ATT_TBL_OFF);
    const size_t tok0 = (size_t)b * SEQ;
    const int qw = qb * 64 + 8 * w;
    const int n64 = qb + 1;
    const GAS bf16* Pb = (const GAS bf16*)F.P + tok0 * LDP;

#ifndef NO_PASS1
    for (int tile = 0; tile < 2; ++tile) {
        int tidv = tid; asm volatile("" : "+v"(tidv));
        const int l32v = tidv & 31, gv = (tidv >> 5) & 1;
        int n64v = n64; asm volatile("" : "+s"(n64v));
        const GAS char* kisrc = (const GAS char*)Pb + ((size_t)(tidv >> 3) * LDP + PC_KI + 8 * (tidv & 7)) * 2;
        const int kidst = ATT_KI_OFF + (tidv >> 3) * ATT_KI_STRIDE + (tidv & 7) * 16;
        const int qq = 2 * ((l32v >> 2) & 1) + (l32v >> 4), hd = ((l32v >> 3) & 1) * 4 + (l32v & 3);
        const GAS bf16* qrow = Pb + (size_t)(qw + 4 * tile + qq) * LDP + PC_QI + hd * 64 + 8 * gv;
        bf16x8 af[4];
#pragma unroll
        for (int ks = 0; ks < 4; ++ks) af[ks] = *(const GAS bf16x8*)(qrow + 16 * ks);
        const int t0q = qw + 4 * tile + 2 * gv;
        float wq[2][8];
#pragma unroll
        for (int e = 0; e < 2; ++e) { const v4u wv = *(const GAS v4u*)(Pb + (size_t)(t0q + e) * LDP + PC_WI);
            wq[e][0] = bf2f_lo(wv.x); wq[e][1] = bf2f_hi(wv.x); wq[e][2] = bf2f_lo(wv.y); wq[e][3] = bf2f_hi(wv.y); wq[e][4] = bf2f_lo(wv.z); wq[e][5] = bf2f_hi(wv.z); wq[e][6] = bf2f_lo(wv.w); wq[e][7] = bf2f_hi(wv.w); }
        unsigned keys[64][2];
        { const v4u st = *(const GAS v4u*)kisrc; *(LAS v4u*)(L + kidst) = st; }
        __syncthreads();
        const int kfoff = ATT_KI_OFF + l32v * ATT_KI_STRIDE + 16 * gv;
#pragma unroll
        for (int t = 0; t < 32; ++t) {
            if (t < n64v) {
                v4u nx = {0u, 0u, 0u, 0u};
                if (t + 1 < n64v) nx = *(const GAS v4u*)(kisrc + (size_t)(t + 1) * (64 * LDP * 2));
#pragma unroll
                for (int j = 0; j < 2; ++j) {
                    const int kt = 2 * t + j;
                    const LAS unsigned char* fp = L + kfoff + (t & 1) * ATT_KI_BUF + j * 32 * ATT_KI_STRIDE;
                    bf16x8 bfr[4];
#pragma unroll
                    for (int ks = 0; ks < 4; ++ks) bfr[ks] = *(const LAS bf16x8*)(fp + 32 * ks);
                    f32x16 acc = {0.f, 0.f, 0.f, 0.f, 0.f, 0.f, 0.f, 0.f, 0.f, 0.f, 0.f, 0.f, 0.f, 0.f, 0.f, 0.f};
#pragma unroll
                    for (int ks = 0; ks < 4; ++ks) acc = __builtin_amdgcn_mfma_f32_32x32x16_bf16(af[ks], bfr[ks], acc, 0, 0, 0);
                    float s0 = 0.f, s1 = 0.f;
#pragma unroll
                    for (int r = 0; r < 8; ++r) { s0 += wq[0][r] * __builtin_amdgcn_fmed3f(acc[r], 0.f, __builtin_inff()); s1 += wq[1][r] * __builtin_amdgcn_fmed3f(acc[8 + r], 0.f, __builtin_inff()); }
                    KEEP4(s0, bfr);
                    const int sidx = 32 * kt + l32v; const unsigned low = 2047u - (unsigned)sidx;
                    keys[kt][0] = (sidx <= t0q) ? ((ord_key(s0) & 0xFFFFF800u) | low) : 0u;
                    keys[kt][1] = (sidx <= t0q + 1) ? ((ord_key(s1) & 0xFFFFF800u) | low) : 0u;
                }
                if (t + 1 < n64v) *(LAS v4u*)(L + kidst + ((t + 1) & 1) * ATT_KI_BUF) = nx;
                __syncthreads();
            } else { keys[2 * t][0] = 0u; keys[2 * t][1] = 0u; keys[2 * t + 1][0] = 0u; keys[2 * t + 1][1] = 0u; }
            __builtin_amdgcn_sched_barrier(0);
        }
        unsigned T0 = 0u, T1 = 0u; bool d0 = false, d1 = false;
        if (t0q + 1 <= NSEL) { T0 = 1u; d0 = true; }
        if (t0q + 2 <= NSEL) { T1 = 1u; d1 = true; }
        for (int bit = 31; bit >= 0; --bit) {
            if (__all(d0 && d1)) break;
            const unsigned c0 = T0 | (1u << bit), c1 = T1 | (1u << bit);
            unsigned cnt = 0u;
#pragma unroll
            for (int gq = 0; gq < 4; ++gq)
                if (8 * gq < n64v) {
#pragma unroll
                    for (int k2 = 0; k2 < 16; ++k2) { cnt += (keys[16 * gq + k2][0] >= c0) ? 1u : 0u; cnt += (keys[16 * gq + k2][1] >= c1) ? 0x10000u : 0u; }
                }
#pragma unroll
            for (int o = 1; o < 32; o <<= 1) cnt += __shfl_xor(cnt, o);
            const unsigned n0 = cnt & 0xffffu, n1 = cnt >> 16;
            if (!d0) { if (n0 >= (unsigned)NSEL) T0 = c0; if (n0 == (unsigned)NSEL) d0 = true; }
            if (!d1) { if (n1 >= (unsigned)NSEL) T1 = c1; if (n1 == (unsigned)NSEL) d1 = true; }
        }
        const int qloc = 8 * w + 4 * tile + 2 * gv;
#pragma unroll
        for (int kt = 0; kt < 64; ++kt)
            if (kt < 2 * n64v) {
                const unsigned long long b0 = __ballot(keys[kt][0] >= T0), b1 = __ballot(keys[kt][1] >= T1);
                if (l32v == 0) { maskL[(qloc + 0) * 64 + kt] = gv ? (unsigned)(b0 >> 32) : (unsigned)b0; maskL[(qloc + 1) * 64 + kt] = gv ? (unsigned)(b1 >> 32) : (unsigned)b1; }
            }
    }

#endif
#ifndef NO_PASS2
    {
        int tid2 = tid; asm volatile("" : "+v"(tid2));
        const int l32 = tid2 & 31, g = (tid2 >> 5) & 1;
        const int ql8 = l32 >> 2, hl = l32 & 3;
        const int tq = qw + ql8;
        const GAS bf16* qrow = Pb + (size_t)tq * LDP + PC_Q + 8 * g;
        bf16x8 qf[2][4];
#pragma unroll
        for (int gk = 0; gk < 2; ++gk)
#pragma unroll
            for (int ks = 0; ks < 4; ++ks) qf[gk][ks] = *(const GAS bf16x8*)(qrow + (4 * gk + hl) * 64 + 16 * ks);
        f32x16 O[2][2];
#pragma unroll
        for (int gk = 0; gk < 2; ++gk)
#pragma unroll
            for (int mt = 0; mt < 2; ++mt)
#pragma unroll
                for (int r = 0; r < 16; ++r) O[gk][mt][r] = 0.f;
        float lsum[2] = {0.f, 0.f}, mrun[2] = {0.f, 0.f};
        const float b31[2] = {tbl[hl * 128 + 127], tbl[(4 + hl) * 128 + 127]};
        const LAS unsigned* mrow = maskL + (8 * w + ql8) * 64;
        const GAS char* ksrc = (const GAS char*)Pb + ((size_t)(tid2 >> 4) * LDP + PC_K + 8 * (tid2 & 15)) * 2;
        const int kdst = ATT_K_OFF + (tid2 >> 4) * ATT_K_STRIDE + (tid2 & 15) * 16;
        const GAS char* vsrc = (const GAS char*)((const GAS bf16*)F.VT + (size_t)b * 128 * SEQ + (size_t)(tid2 >> 3) * SEQ + 8 * (tid2 & 7));
        const int vdst = ATT_VT_OFF + (tid2 >> 3) * ATT_VT_STRIDE + (tid2 & 7) * 16;
        v4u kx[2], vx[2];
#define ATT_LOAD(t_) do { kx[0] = *(const GAS v4u*)(ksrc + (size_t)(t_) * (64 * LDP * 2)); kx[1] = *(const GAS v4u*)(ksrc + (size_t)(t_) * (64 * LDP * 2) + (size_t)32 * LDP * 2); \
        vx[0] = *(const GAS v4u*)(vsrc + (size_t)(t_) * 128); vx[1] = *(const GAS v4u*)(vsrc + (size_t)(t_) * 128 + (size_t)64 * SEQ * 2); } while (0)
#define ATT_STORE(buf_) do { *(LAS v4u*)(L + kdst + (buf_) * ATT_K_BUF) = kx[0]; *(LAS v4u*)(L + kdst + (buf_) * ATT_K_BUF + 32 * ATT_K_STRIDE) = kx[1]; \
        *(LAS u32x2*)(L + vdst + (buf_) * ATT_VT_BUF) = (u32x2){vx[0].x, vx[0].y}; *(LAS u32x2*)(L + vdst + (buf_) * ATT_VT_BUF + 8) = (u32x2){vx[0].z, vx[0].w}; \
        *(LAS u32x2*)(L + vdst + (buf_) * ATT_VT_BUF + 64 * ATT_VT_STRIDE) = (u32x2){vx[1].x, vx[1].y}; *(LAS u32x2*)(L + vdst + (buf_) * ATT_VT_BUF + 64 * ATT_VT_STRIDE + 8) = (u32x2){vx[1].z, vx[1].w}; } while (0)
        ATT_LOAD(0); ATT_STORE(0);
        __syncthreads();
        const int kfo = ATT_K_OFF + l32 * ATT_K_STRIDE + 16 * g;
        const int vfo = ATT_VT_OFF + l32 * ATT_VT_STRIDE + 8 * g;
        for (int t = 0; t < n64; ++t) {
            if (t + 1 < n64) ATT_LOAD(t + 1);
            const int bufk = (t & 1) * ATT_K_BUF, bufv = (t & 1) * ATT_VT_BUF;
            bf16x8 pf[2]; pf[0] = (bf16x8){0, 0, 0, 0, 0, 0, 0, 0}; pf[1] = pf[0];
#pragma unroll
            for (int i = 0; i < 5; ++i) {
                const int j = (i >> 1) & 1, gk = i & 1, jp = ((i - 1) >> 1) & 1, gp = (i - 1) & 1;
                __builtin_amdgcn_sched_barrier(0);
                bf16x8 vf[2][2], kf[4];
                if (i > 0) {
#pragma unroll
                    for (int mt = 0; mt < 2; ++mt)
#pragma unroll
                        for (int s = 0; s < 2; ++s) { const LAS unsigned char* vp = L + vfo + bufv + (gp * 64 + 32 * mt) * ATT_VT_STRIDE + jp * 64 + 32 * s;
                            const u32x2 lo = *(const LAS u32x2*)vp, hi = *(const LAS u32x2*)(vp + 16); v4u vv = {lo.x, lo.y, hi.x, hi.y}; vf[mt][s] = __builtin_bit_cast(bf16x8, vv); }
                }
                if (i < 4) {
#pragma unroll
                    for (int ks = 0; ks < 4; ++ks) kf[ks] = *(const LAS bf16x8*)(L + kfo + bufk + j * 32 * ATT_K_STRIDE + gk * 128 + 32 * ks);
                }
                if (i > 0) {
#pragma unroll
                    for (int s = 0; s < 2; ++s)
#pragma unroll
                        for (int mt = 0; mt < 2; ++mt) O[gp][mt] = __builtin_amdgcn_mfma_f32_32x32x16_bf16(vf[mt][s], pf[s], O[gp][mt], 0, 0, 0);
                }
                if (i < 4) {
                    const int kt = 2 * t + j;
                    f32x16 S = {0.f, 0.f, 0.f, 0.f, 0.f, 0.f, 0.f, 0.f, 0.f, 0.f, 0.f, 0.f, 0.f, 0.f, 0.f, 0.f};
#pragma unroll
                    for (int ks = 0; ks < 4; ++ks) S = __builtin_amdgcn_mfma_f32_32x32x16_bf16(kf[ks], qf[gk][ks], S, 0, 0, 0);
                    const unsigned mg = mrow[kt] >> (4 * g);
                    const bool far = (qw - (32 * kt + 31)) >= 113;
                    float x[16];
                    if (far) { const float cb = b31[gk] - mrun[gk];
#pragma unroll
                        for (int r = 0; r < 16; ++r) x[r] = S[r] + cb;
                    } else { const LAS float* tb = tbl + (4 * gk + hl) * 128; int dbase = tq - 32 * kt - 4 * g; asm volatile("" : "+v"(dbase)); const float mr = mrun[gk];
#pragma unroll
                        for (int r = 0; r < 16; ++r) { int dd = dbase - ((r & 3) + 8 * (r >> 2)); dd = dd < 0 ? 0 : (dd > 127 ? 127 : dd); x[r] = S[r] + (tb[dd] - mr); }
                    }
                    KEEP4(x[0], kf);
                    if (i > 0) asm volatile("" : "+v"(x[0]) : "v"(vf[0][0]), "v"(vf[0][1]), "v"(vf[1][0]), "v"(vf[1][1]), "v"(pf[0]), "v"(pf[1]));
                    float tm = x[0];
#pragma unroll
                    for (int r = 1; r < 16; ++r) tm = fmaxf(tm, x[r]);
                    tm = fmaxf(tm, __shfl_xor(tm, 32));
                    if (kt == 0) { mrun[gk] = tm;
#pragma unroll
                        for (int r = 0; r < 16; ++r) x[r] -= tm;
                    } else if (__any(tm > 8.f)) {
                        const float dl = fmaxf(tm, 0.f), alpha = __builtin_amdgcn_exp2f(-dl);
                        mrun[gk] += dl; lsum[gk] *= alpha;
#pragma unroll
                        for (int r = 0; r < 16; ++r) x[r] -= dl;
#pragma unroll
                        for (int mt = 0; mt < 2; ++mt)
#pragma unroll
                            for (int r = 0; r < 16; ++r) O[gk][mt][r] *= alpha;
                    }
                    float ps = 0.f; unsigned pk[8];
#pragma unroll
                    for (int r = 0; r < 16; r += 2) {
                        const int bp0 = 8 * (r >> 2) + (r & 3), bp1 = 8 * ((r + 1) >> 2) + ((r + 1) & 3);
                        const unsigned sm0 = (unsigned)(((int)(mg << (31 - bp0))) >> 31), sm1 = (unsigned)(((int)(mg << (31 - bp1))) >> 31);
                        const float p0 = __uint_as_float(__float_as_uint(__builtin_amdgcn_exp2f(x[r])) & sm0), p1 = __uint_as_float(__float_as_uint(__builtin_amdgcn_exp2f(x[r + 1])) & sm1);
                        ps += p0 + p1; pk[r >> 1] = cvtpk(p0, p1);
                    }
                    lsum[gk] += ps;
                    { v4u t0 = {pk[0], pk[1], pk[2], pk[3]}, t1 = {pk[4], pk[5], pk[6], pk[7]}; pf[0] = __builtin_bit_cast(bf16x8, t0); pf[1] = __builtin_bit_cast(bf16x8, t1); }
                    if (i == 0 && t + 1 < n64) ATT_STORE((t + 1) & 1);
                } else {
                    __builtin_amdgcn_sched_barrier(0);
                    asm volatile("s_nop 15"); asm volatile("s_nop 15"); asm volatile("s_nop 15"); asm volatile("s_nop 15");
                    asm volatile("s_nop 15"); asm volatile("s_nop 15"); asm volatile("s_nop 15"); asm volatile("s_nop 15");
                    asm volatile("" :: "v"(vf[0][0]), "v"(vf[0][1]), "v"(vf[1][0]), "v"(vf[1][1]), "v"(pf[0]), "v"(pf[1]));
                    __builtin_amdgcn_sched_barrier(0);
                }
            }
            __syncthreads();
        }
#undef ATT_LOAD
#undef ATT_STORE
        bf16* orow = F.AR + (tok0 + tq) * LDAR;
#pragma unroll
        for (int gk = 0; gk < 2; ++gk) {
            const float lt = lsum[gk] + __shfl_xor(lsum[gk], 32), inv = 1.0f / lt;
#pragma unroll
            for (int mt = 0; mt < 2; ++mt)
#pragma unroll
                for (int i = 0; i < 4; ++i) { const int d = 32 * mt + 8 * i + 4 * g;
                    u32x2 wv; wv.x = cvtpk(O[gk][mt][4 * i] * inv, O[gk][mt][4 * i + 1] * inv); wv.y = cvtpk(O[gk][mt][4 * i + 2] * inv, O[gk][mt][4 * i + 3] * inv);
                    *(u32x2*)(orow + (4 * gk + hl) * 64 + d) = wv; }
        }
    }
#endif
}

constexpr int LRU_XCF = 0, LRU_ABF = 32768, LRU_ABF_STRIDE = 272, LRU_RAW = 51200, LRU_GY = 69632, LRU_OUT = 86016;
__device__ __forceinline__ void lru_unit(Frame& F, int b, int n) {
    const int tid = F.tid, lane = F.lane, w = F.wave, l16 = lane & 15, q = lane >> 4;
    LAS unsigned char* L = F.lds + RING_OFF;
    LAS float* XCF = (LAS float*)(L + LRU_XCF);
    LAS unsigned char* ABF = L + LRU_ABF;
    LAS bf16* RAW = (LAS bf16*)(L + LRU_RAW);
    LAS bf16* GY = (LAS bf16*)(L + LRU_GY);
    LAS bf16* OUTS = (LAS bf16*)(L + LRU_OUT);
    const size_t tok0 = (size_t)b * SEQ;
    const bf16* Pb = F.P + tok0 * LDP;
    const int ch0 = n * 128;
    bf16x8 brg[4], big[4];
    { const bf16* wr = F.Wrg_t + (size_t)n * 16384 + (16 * w + l16) * 128 + 8 * q; const bf16* wi = F.Wig_t + (size_t)n * 16384 + (16 * w + l16) * 128 + 8 * q;
#pragma unroll
      for (int ks = 0; ks < 4; ++ks) { brg[ks] = *(const bf16x8*)(wr + 32 * ks); big[ks] = *(const bf16x8*)(wi + 32 * ks); } }
    const int dch = ch0 + 16 * w + l16;
    const float brg_b = F.b_rg[dch], big_b = F.b_ig[dch];
    const float lam = F.lru_lambda[dch];
    const float sp = fmaxf(-lam, 0.f) + log1pf(expf(-fabsf(lam)));
    const float a_coef = -8.0f * sp;
    const int cc = tid & 127, tseg = tid >> 7;
    const float cw0 = F.conv_rnn_w[0 * D + ch0 + cc], cw1 = F.conv_rnn_w[1 * D + ch0 + cc], cw2 = F.conv_rnn_w[2 * D + ch0 + cc], cw3 = F.conv_rnn_w[3 * D + ch0 + cc], cbias = F.conv_rnn_b[ch0 + cc];
    float hprev = 0.f;
    const LAS float* xcb = XCF + (4 * q) * 128 + 16 * w + l16; const LAS bf16* gyb = GY + (4 * q) * 128 + 16 * w + l16; LAS bf16* outb = OUTS + (4 * q) * 128 + 16 * w + l16;
    v4u raw[3], gyr[2];
#define LRU_LOAD(t0_) do { _Pragma("unroll") for (int i_ = 0; i_ < 3; ++i_) { const int idx_ = tid + 512 * i_; raw[i_] = (v4u){0u, 0u, 0u, 0u}; \
            if (idx_ < 67 * 16) { const int row_ = idx_ >> 4, part_ = idx_ & 15, t_ = (t0_) - 3 + row_; if (t_ >= 0) raw[i_] = *(const v4u*)(Pb + (size_t)t_ * LDP + PC_XR + ch0 + 8 * part_); } } \
        _Pragma("unroll") for (int i_ = 0; i_ < 2; ++i_) { const int idx_ = tid + 512 * i_, row_ = idx_ >> 4, part_ = idx_ & 15; gyr[i_] = *(const v4u*)(Pb + (size_t)((t0_) + row_) * LDP + PC_YR + ch0 + 8 * part_); } } while (0)
    LRU_LOAD(0);
    for (int chunk = 0; chunk < SEQ / 64; ++chunk) {
        const int t0 = chunk * 64;
#pragma unroll
        for (int i = 0; i < 3; ++i) { const int idx = tid + 512 * i; if (idx < 67 * 16) *(LAS v4u*)(RAW + idx * 8) = raw[i]; }
#pragma unroll
        for (int i = 0; i < 2; ++i) { const int idx = tid + 512 * i; *(LAS v4u*)(GY + idx * 8) = gyr[i]; }
        __syncthreads();
        if (chunk + 1 < SEQ / 64) LRU_LOAD(t0 + 64);
        { float x0 = bf1(RAW[(16 * tseg + 0) * 128 + cc]), x1 = bf1(RAW[(16 * tseg + 1) * 128 + cc]), x2 = bf1(RAW[(16 * tseg + 2) * 128 + cc]);
#pragma unroll
          for (int tt = 0; tt < 16; ++tt) { const int t = 16 * tseg + tt; const float x3 = bf1(RAW[(t + 3) * 128 + cc]);
              const float xc = cbias + cw0 * x0 + cw1 * x1 + cw2 * x2 + cw3 * x3;
              XCF[t * 128 + cc] = xc; *(LAS bf16*)(ABF + t * LRU_ABF_STRIDE + cc * 2) = (bf16)f2bf(xc);
              x0 = x1; x1 = x2; x2 = x3; } }
        __syncthreads();
        float Ap[4][4], Hl[4][4], Aex[4], Hex[4], Atl[4], Htl[4];
#pragma unroll
        for (int rt = 0; rt < 4; ++rt) {
            f32x4 accR = {0.f, 0.f, 0.f, 0.f}, accI = {0.f, 0.f, 0.f, 0.f};
            const LAS unsigned char* ap = ABF + (16 * rt + l16) * LRU_ABF_STRIDE + 16 * q;
            bf16x8 af[4];
#pragma unroll
            for (int ks = 0; ks < 4; ++ks) af[ks] = *(const LAS bf16x8*)(ap + 64 * ks);
#pragma unroll
            for (int ks = 0; ks < 4; ++ks) { accR = __builtin_amdgcn_mfma_f32_16x16x32_bf16(af[ks], brg[ks], accR, 0, 0, 0); accI = __builtin_amdgcn_mfma_f32_16x16x32_bf16(af[ks], big[ks], accI, 0, 0, 0); }
#pragma unroll
            for (int r = 0; r < 4; ++r) { const float xc = xcb[(16 * rt + r) * 128];
                float rr = sigmoidf_(accR[r] + brg_b); const float ii = sigmoidf_(accI[r] + big_b);
                if (r == 0) asm volatile("" : "+v"(rr) : "v"(af[0]), "v"(af[1]), "v"(af[2]), "v"(af[3]));
                const float la = a_coef * rr, a = __builtin_amdgcn_exp2f(la * LOG2E);
                const float x2 = la + la;
                const float pm = x2 * (1.f + x2 * (0.5f + x2 * (0.16666667f + x2 * (0.041666668f + x2 * (0.0083333338f + x2 * 0.0013888889f)))));
                const float om = (x2 > -0.25f) ? -pm : (1.f - a * a);
                const float u = xc * ii * __builtin_amdgcn_sqrtf(om);
                if (r == 0) { Ap[rt][0] = a; Hl[rt][0] = u; } else { Ap[rt][r] = Ap[rt][r - 1] * a; Hl[rt][r] = a * Hl[rt][r - 1] + u; } }
            float A = Ap[rt][3], H = Hl[rt][3];
            { const float Au = __shfl_up(A, 16), Hu = __shfl_up(H, 16); if (q >= 1) { H = A * Hu + H; A = A * Au; } }
            { const float Au = __shfl_up(A, 32), Hu = __shfl_up(H, 32); if (q >= 2) { H = A * Hu + H; A = A * Au; } }
            float Ae = __shfl_up(A, 16), He = __shfl_up(H, 16); if (q == 0) { Ae = 1.f; He = 0.f; }
            Aex[rt] = Ae; Hex[rt] = He; Atl[rt] = __shfl(A, 48 + l16); Htl[rt] = __shfl(H, 48 + l16);
        }
#pragma unroll
        for (int rt = 0; rt < 4; ++rt) {
            const float hin = Hex[rt] + Aex[rt] * hprev;
            hprev = Htl[rt] + Atl[rt] * hprev;
#pragma unroll
            for (int r = 0; r < 4; ++r) { const float h = Hl[rt][r] + Ap[rt][r] * hin; const float gv = bf1(gyb[(16 * rt + r) * 128]);
                outb[(16 * rt + r) * 128] = (bf16)f2bf(h * gv); }
        }
        __syncthreads();
#pragma unroll
        for (int i = 0; i < 2; ++i) { const int idx = tid + 512 * i, row = idx >> 4, part = idx & 15;
            *(v4u*)(F.AR + (tok0 + t0 + row) * LDAR + 512 + ch0 + 8 * part) = *(const LAS v4u*)(OUTS + idx * 8); }
    }
#undef LRU_LOAD
}

__device__ __forceinline__ void p3_mixers(Frame& F) {
    { LAS float* tbl = (LAS float*)(F.lds + RING_OFF + ATT_TBL_OFF);
      for (int i = F.tid; i < 8 * 128; i += NWAVES * 64) { const int h = i >> 7, d = i & 127; tbl[i] = F.rel_bias[(int)T5_BUCKET[d] * NH + h] * LOG2E; } }
    __syncthreads();
    for (int e = F.vcu; e < 1024; e += F.G) {
        const int k = e >> 8, r = e & 255, b = r >> 3, j = r & 7;
        const int qb = (k == 0) ? 31 - j : (k == 1) ? 16 + j : (k == 2) ? 15 - j : j;
#ifndef NO_ATT
        attn_unit(F, b, qb);
#else
        for (int i = F.tid; i < 64 * 64; i += NWAVES * 64) { const int row = i >> 6, part = i & 63; *(v4u*)(F.AR + ((size_t)b * SEQ + qb * 64 + row) * LDAR + 8 * part) = (v4u){0u, 0u, 0u, 0u}; }
#endif
    }
    __syncthreads();
#ifndef NO_LRU
    for (int u = F.vcu; u < BATCH * 8; u += F.G) lru_unit(F, u >> 3, u & 7);
#ifdef DUP_LRU
    __syncthreads();
    for (int u = F.vcu; u < BATCH * 8; u += F.G) lru_unit(F, u >> 3, u & 7);
#endif
#else
    for (int u = F.vcu; u < BATCH * 8; u += F.G) { const int b = u >> 3, n = u & 7;
        for (int i = F.tid; i < SEQ * 16; i += NWAVES * 64) { const int row = i >> 4, part = i & 15; *(v4u*)(F.AR + ((size_t)b * SEQ + row) * LDAR + 512 + n * 128 + 8 * part) = (v4u){0u, 0u, 0u, 0u}; } }
#endif
}

#ifndef MK_N_LAUNCHES
#define MK_N_LAUNCHES 1
#endif
constexpr int N_PHASES = 12;

#define CAS __attribute__((address_space(4)))
__device__ __forceinline__ void frame_ptrs(Frame& F) {
    const CAS unsigned long long* kp = (const CAS unsigned long long*)__builtin_amdgcn_kernarg_segment_ptr();
    asm volatile("" : "+s"(kp));
    { int t_ = threadIdx.x; asm volatile("" : "+v"(t_)); F.tid = t_; F.lane = t_ & 63; }
#define KIN(k) ((const float*)(const GAS float*)kp[k])
    F.x = KIN(0); F.c = KIN(1); F.w_ada = KIN(2); F.b_ada = KIN(3); F.g_mix = KIN(4); F.w_in = KIN(5); F.b_in = KIN(6); F.rel_bias = KIN(7);
    F.conv_rnn_w = KIN(8); F.conv_rnn_b = KIN(9); F.w_rg = KIN(10); F.b_rg = KIN(11); F.w_ig = KIN(12); F.b_ig = KIN(13); F.lru_lambda = KIN(14);
    F.w_o_attn = KIN(15); F.w_o_rnn = KIN(16); F.w_out = KIN(17); F.g_ffn = KIN(18); F.w_up = KIN(19); F.conv_ffn_w = KIN(20); F.conv_ffn_b = KIN(21);
    F.w_down = KIN(22); F.g_final = KIN(23);
#undef KIN
    F.out = (float*)(GAS float*)kp[24];
    GAS unsigned char* ws = (GAS unsigned char*)kp[25];
    F.mod = (float*)(ws + WS_MOD); F.biasp = (float*)(ws + WS_BIASP); F.hpart = (float*)(ws + WS_C); F.hx = (float*)(ws + WS_C + 16 * MiB);
    F.Win_t = (bf16*)(ws + WS_WIN); F.Wup_t = (bf16*)(ws + WS_WUP); F.Wdn_t = (bf16*)(ws + WS_WDN); F.Woa_t = (bf16*)(ws + WS_WOA); F.Wor_t = (bf16*)(ws + WS_WOR); F.Wout_t = (bf16*)(ws + WS_WOUT);
    F.Wrg_t = (bf16*)(ws + WS_WRG); F.Wig_t = (bf16*)(ws + WS_WIG);
    F.VT = (bf16*)(ws + WS_VT); F.P = (bf16*)(ws + WS_A); F.UPH = (bf16*)(ws + WS_A); F.ACT = (bf16*)(ws + WS_ACT); F.XN = (bf16*)(ws + WS_B); F.T1 = (bf16*)(ws + WS_B); F.MG = (bf16*)(ws + WS_C);
    F.AR = (bf16*)(GAS bf16*)kp[24];
}
struct Args { const float* in[24]; float* out; unsigned char* ws; int ph_lo, ph_hi; };
__global__ void __launch_bounds__(NWAVES * 64, 2) mk_fwd(Args args) {
    extern __shared__ __attribute__((aligned(16))) unsigned char lds[];
    Frame F;
    F.lds = (LAS unsigned char*)lds;
    F.MISC = (volatile LAS unsigned*)(F.lds + MISC_OFF);
    F.tid = threadIdx.x; F.lane = F.tid & 63; F.wave = __builtin_amdgcn_readfirstlane(F.tid >> 6);
    F.G = gridDim.x; { const int bx = blockIdx.x; F.vcu = (F.G % 8 == 0) ? (bx % 8) * (F.G / 8) + bx / 8 : bx; }
    F.ctl = (gu32*)(args.ws + WS_CTL);
    for (int u = F.tid; u < (LDS_BYTES - LDSCTL_OFF) / 4; u += NWAVES * 64) ((LAS unsigned*)(F.lds + LDSCTL_OFF))[u] = 0u;
    __syncthreads();
    const int lo = args.ph_lo, hi = args.ph_hi;
    XcdBarrier bar; bar.bar = (unsigned*)(F.ctl + CW_BAR); bar.x = 0; bar.st = nullptr;
    if (hi - lo > 1) bar = xcd_barrier_post((unsigned*)(F.ctl + CW_BAR), F.MISC + 8);
#ifndef PHASE_MASK
#define PHASE_MASK 0xFFFFu
#endif
#define IN(k) (((PHASE_MASK >> (k)) & 1u) && lo <= (k) && (k) < hi)
#ifndef DUP_MASK
#define DUP_MASK 0u
#endif
#define REP(k) for (int rep_ = 0; rep_ < ((((DUP_MASK) >> (k)) & 1u) ? 2 : 1); ++rep_)
#define SEAM(k) do { if (IN(k) && IN((k) + 1)) xcd_barrier(bar); } while (0)
    typedef pg8::bf16_t gb;

    if (IN(0)) REP(0) { if (rep_) __syncthreads(); frame_ptrs(F); p0_prologue(F); } SEAM(0);
    if (IN(1)) REP(1) { if (rep_) __syncthreads(); frame_ptrs(F); p_norm_mod(F, F.x, F.XN, F.g_mix, 0 * D, 1 * D); } SEAM(1);
    if (IN(2)) REP(2) { if (rep_) __syncthreads(); frame_ptrs(F);
        pg8::Gemm g{(const gb*)F.XN, (const gb*)F.Win_t, M, LDP, D, D, D}; pg8::StaticOrder S; S.init(M, LDP, F.G, (int)blockIdx.x);
        pg8::EpiProj E{(gb*)F.P, LDP, F.biasp, (gb*)F.VT, SEQ, QSCALE};
        pg8::gemm_phase<pg8::EpiProj, pg8::StaticOrder, true, true>(F.lds + RING_OFF, g, S, E);
    } SEAM(2);
    if (IN(3)) REP(3) { if (rep_) __syncthreads(); frame_ptrs(F); p3_mixers(F); } SEAM(3);
    if (IN(4)) REP(4) { if (rep_) __syncthreads(); frame_ptrs(F);
        pg8::Gemm g{(const gb*)F.AR, (const gb*)F.Woa_t, M, D, 512, LDAR, 512}; pg8::StaticOrder S; S.init(M, D, F.G, (int)blockIdx.x);
        pg8::EpiGate<false> E{(const gb*)F.P + PC_GA, LDP, nullptr, (gb*)F.T1, D};
        pg8::gemm_phase<pg8::EpiGate<false>, pg8::StaticOrder, true, true>(F.lds + RING_OFF, g, S, E);
    } SEAM(4);
    if (IN(5)) REP(5) { if (rep_) __syncthreads(); frame_ptrs(F);
        pg8::Gemm g{(const gb*)F.AR + 512, (const gb*)F.Wor_t, M, D, D, LDAR, D}; pg8::StaticOrder S; S.init(M, D, F.G, (int)blockIdx.x);
        pg8::EpiGate<true> E{(const gb*)F.P + PC_GB, LDP, (const gb*)F.T1, (gb*)F.MG, D};
        pg8::gemm_phase<pg8::EpiGate<true>, pg8::StaticOrder, true, true>(F.lds + RING_OFF, g, S, E);
    } SEAM(5);
    if (IN(6)) REP(6) { if (rep_) __syncthreads(); frame_ptrs(F);
        pg8::Gemm g{(const gb*)F.MG, (const gb*)F.Wout_t, M, D, D, D, D}; pg8::StaticOrder S; S.init(M, D, F.G, (int)blockIdx.x);
        pg8::EpiResid E{F.x, F.out, D, F.mod + 2 * D, NMOD, SEQ};
        pg8::gemm_phase<pg8::EpiResid, pg8::StaticOrder, true, true>(F.lds + RING_OFF, g, S, E);
    } SEAM(6);
    if (IN(7)) REP(7) { if (rep_) __syncthreads(); frame_ptrs(F); p_norm_mod(F, F.out, F.XN, F.g_ffn, 3 * D, 4 * D); } SEAM(7);
    if (IN(8)) REP(8) { if (rep_) __syncthreads(); frame_ptrs(F);
        pg8::Gemm g{(const gb*)F.XN, (const gb*)F.Wup_t, M, 2 * DFF, D, D, D}; pg8::StaticOrder S; S.init(M, 2 * DFF, F.G, (int)blockIdx.x);
        pg8::EpiUpConv E{(gb*)F.ACT, DFF, F.conv_ffn_w, F.conv_ffn_b, F.hpart, F.hx, (LAS float*)(F.lds + LDSCTL_OFF + 1024), SEQ};
        pg8::gemm_phase<pg8::EpiUpConv, pg8::StaticOrder, true, true>(F.lds + RING_OFF, g, S, E);
    } SEAM(8);
    if (IN(9)) REP(9) { if (rep_) __syncthreads(); frame_ptrs(F); p_ffn_fix(F); } SEAM(9);
    if (IN(10)) REP(10) { if (rep_) __syncthreads(); frame_ptrs(F);
        pg8::Gemm g{(const gb*)F.ACT, (const gb*)F.Wdn_t, M, D, DFF, DFF, DFF}; pg8::StaticOrder S; S.init(M, D, F.G, (int)blockIdx.x);
        pg8::EpiResid E{F.out, F.out, D, F.mod + 5 * D, NMOD, SEQ};
        pg8::gemm_phase<pg8::EpiResid, pg8::StaticOrder, true, true>(F.lds + RING_OFF, g, S, E);
    } SEAM(10);
    if (IN(11)) REP(11) { if (rep_) __syncthreads(); frame_ptrs(F); p_norm_final(F); }
#undef IN
#undef SEAM
}

extern "C" void kernel_launch(void* const* d_in, const int* in_sizes, int n_in, void* d_out, int out_size, void* d_ws, size_t ws_size, hipStream_t stream) {
    static int grid = 0;
    if (grid == 0) {
        if (n_in != 24 || in_sizes[0] != M * D || out_size != M * D || ws_size < WS_END) { fprintf(stderr, "kernel_launch: unexpected shapes (n_in %d, in0 %d, out %d, ws %zu); nothing launched\n", n_in, n_in > 0 ? in_sizes[0] : -1, out_size, ws_size); grid = -1; return; }
        int dev = 0, cus = 0, per_cu = 0;
        if (hipGetDevice(&dev) != hipSuccess || hipDeviceGetAttribute(&cus, hipDeviceAttributeMultiprocessorCount, dev) != hipSuccess) { grid = -1; return; }
        if (hipFuncSetAttribute((const void*)mk_fwd, hipFuncAttributeMaxDynamicSharedMemorySize, LDS_BYTES) != hipSuccess) { fprintf(stderr, "kernel_launch: hipFuncSetAttribute failed\n"); grid = -1; return; }
        if (hipOccupancyMaxActiveBlocksPerMultiprocessor(&per_cu, (const void*)mk_fwd, NWAVES * 64, LDS_BYTES) != hipSuccess || per_cu < 1) { fprintf(stderr, "kernel_launch: occupancy query reports %d blocks per CU\n", per_cu); }
        (void)hipGetLastError();
        grid = cus;
    }
    if (grid < 0) return;
    if (hipMemsetAsync((char*)d_ws + WS_CTL, 0, CTL_ZERO_BYTES, stream) != hipSuccess) { fprintf(stderr, "kernel_launch: memset failed\n"); return; }
    Args a{};
    for (int i = 0; i < 24; ++i) a.in[i] = (const float*)d_in[i];
    a.out = (float*)d_out; a.ws = (unsigned char*)d_ws;
#if MK_N_LAUNCHES == 1
    a.ph_lo = 0; a.ph_hi = N_PHASES;
    hipLaunchKernelGGL(mk_fwd, dim3(grid), dim3(NWAVES * 64), LDS_BYTES, stream, a);
#else
    for (int p = 0; p < N_PHASES; ++p) { a.ph_lo = p; a.ph_hi = p + 1; hipLaunchKernelGGL(mk_fwd, dim3(grid), dim3(NWAVES * 64), LDS_BYTES, stream, a); }
#endif
    const hipError_t le = hipPeekAtLastError();
    if (le != hipSuccess) fprintf(stderr, "kernel_launch: launch failed: %s\n", hipGetErrorName(le));
}
```
